# Optimizing an MI355X kernel written in HIP

```python
import jax, jax.numpy as jnp
from jax import lax
import numpy as np

D_MODEL = 1024
BATCH = 4
SEQ = 4096
DEPTH = 2

POOL_WIDTH = 512
POOL_WINDOWS = (2, 4, 8, 16)
N_POOL_GROUPS = len(POOL_WINDOWS)
POOL_GROUP = POOL_WIDTH // N_POOL_GROUPS
N_Q_HEADS = 8
N_KV_HEADS = 2
HEAD_DIM = 64
Q_GROUP = N_Q_HEADS // N_KV_HEADS
Q_WIDTH = N_Q_HEADS * HEAD_DIM
KV_WIDTH = N_KV_HEADS * HEAD_DIM
WINDOW = 128
BLOCK = 128
N_BRANCHES = 2
IN_WIDTH = POOL_WIDTH + Q_WIDTH + 2 * KV_WIDTH + N_BRANCHES * D_MODEL
D_FF = ((8 * D_MODEL + 3 * 256 - 1) // (3 * 256)) * 256
EPS = 1e-6

kernel_name = "hybrid_pool_swa_gated_encoder"


def rms_norm(x, gain):
    xf = x.astype(jnp.float32)
    y = xf * lax.rsqrt(jnp.mean(xf * xf, axis=-1, keepdims=True) + EPS)
    return (y * gain.astype(jnp.float32)).astype(x.dtype)


def alibi_slopes():
    h = jnp.arange(1, N_Q_HEADS + 1, dtype=jnp.float32)
    return jnp.exp2(-8.0 * h / N_Q_HEADS)


def multiscale_pool(z, w_group, scale):
    B, S, _ = z.shape
    zf = z.astype(jnp.float32)
    cs = jnp.pad(jnp.cumsum(zf, axis=1), ((0, 0), (1, 0), (0, 0)))
    t = jnp.arange(S)
    outs = []
    for g, w in enumerate(POOL_WINDOWS):
        sl = slice(g * POOL_GROUP, (g + 1) * POOL_GROUP)
        lo = jnp.clip(t - w // 2, 0, S)
        hi = jnp.clip(t + w // 2, 0, S)
        csg = cs[..., sl]
        count = (hi - lo).astype(jnp.float32)[None, :, None]
        mean = (csg[:, hi] - csg[:, lo]) / count
        outs.append(mean - zf[..., sl])
    d = jnp.stack(outs, axis=2).astype(z.dtype)
    y = jnp.einsum("bsgc,gcd->bsgd", d, w_group).reshape(B, S, POOL_WIDTH)
    return y * scale


def band_blocks(t, nb):
    B = t.shape[0]
    t = jnp.pad(t, ((0, 0), (BLOCK, BLOCK), (0, 0), (0, 0)))
    t = t.reshape(B, nb + 2, BLOCK, N_KV_HEADS, HEAD_DIM)
    return jnp.concatenate([t[:, :-2], t[:, 1:-1], t[:, 2:]], axis=2)


def windowed_gqa(q, k, v, sink):
    B, S, _ = q.shape
    nb = S // BLOCK
    qb = (q * (HEAD_DIM ** -0.5)).reshape(B, nb, BLOCK, N_KV_HEADS, Q_GROUP, HEAD_DIM)
    kb = band_blocks(k.reshape(B, S, N_KV_HEADS, HEAD_DIM), nb)
    vb = band_blocks(v.reshape(B, S, N_KV_HEADS, HEAD_DIM), nb)
    scores = jnp.einsum("bnqhgd,bnkhd->bnhgqk", qb, kb).astype(jnp.float32)
    a = jnp.arange(BLOCK)[:, None]
    c = jnp.arange(3 * BLOCK)[None, :]
    absdist = jnp.abs(a - c + BLOCK)
    kpos = (jnp.arange(nb)[:, None] - 1) * BLOCK + jnp.arange(3 * BLOCK)[None, :]
    kvalid = (kpos >= 0) & (kpos < S)
    mask = (absdist <= WINDOW)[None, :, :] & kvalid[:, None, :]
    slopes = alibi_slopes().reshape(N_KV_HEADS, Q_GROUP)[:, :, None, None]
    scores = scores - slopes * absdist.astype(jnp.float32)
    scores = jnp.where(mask[None, :, None, None, :, :], scores, -jnp.inf)
    sink_l = sink.astype(jnp.float32).reshape(N_KV_HEADS, Q_GROUP)[:, :, None, None]
    m = jnp.maximum(jnp.max(scores, axis=-1, keepdims=True), sink_l)
    p = jnp.exp(scores - m)
    denom = jnp.sum(p, axis=-1, keepdims=True) + jnp.exp(sink_l - m)
    p = (p / denom).astype(v.dtype)
    out = jnp.einsum("bnhgqk,bnkhd->bnqhgd", p, vb)
    return out.reshape(B, S, Q_WIDTH)


def setup_inputs(seed: int = 0) -> dict:
    key = jax.random.key(seed)
    ks = jax.random.split(key, 16)
    f32 = jnp.float32

    def dense(k, shape, fan_in):
        return jax.random.normal(k, shape, f32) * (fan_in ** -0.5)

    def gain(k, shape):
        return 1.0 + 0.05 * jax.random.normal(k, shape, f32)

    return {
        "x": jax.random.normal(ks[0], (BATCH, SEQ, D_MODEL), f32),
        "norm_mix": gain(ks[1], (DEPTH, D_MODEL)),
        "w_in": dense(ks[2], (DEPTH, D_MODEL, IN_WIDTH), D_MODEL),
        "w_pool_group": dense(ks[3], (DEPTH, N_POOL_GROUPS, POOL_GROUP, POOL_GROUP), POOL_GROUP),
        "pool_scale": gain(ks[4], (DEPTH, POOL_WIDTH)),
        "sink": 0.5 * jax.random.normal(ks[5], (DEPTH, N_Q_HEADS), f32),
        "w_pool_branch": dense(ks[6], (DEPTH, POOL_WIDTH, D_MODEL), POOL_WIDTH),
        "w_attn_branch": dense(ks[7], (DEPTH, Q_WIDTH, D_MODEL), Q_WIDTH),
        "w_out": dense(ks[8], (DEPTH, D_MODEL, D_MODEL), D_MODEL),
        "norm_ffn": gain(ks[9], (DEPTH, D_MODEL)),
        "w_ffn_gate": dense(ks[10], (DEPTH, D_MODEL, D_FF), D_MODEL),
        "w_ffn_up": dense(ks[11], (DEPTH, D_MODEL, D_FF), D_MODEL),
        "w_ffn_down": dense(ks[12], (DEPTH, D_FF, D_MODEL), D_FF),
        "norm_final": gain(ks[13], (D_MODEL,)),
    }


def reference(x, norm_mix, w_in, w_pool_group, pool_scale, sink, w_pool_branch,
              w_attn_branch, w_out, norm_ffn, w_ffn_gate, w_ffn_up, w_ffn_down, norm_final):
    splits = [POOL_WIDTH,
              POOL_WIDTH + Q_WIDTH,
              POOL_WIDTH + Q_WIDTH + KV_WIDTH,
              POOL_WIDTH + Q_WIDTH + 2 * KV_WIDTH,
              POOL_WIDTH + Q_WIDTH + 2 * KV_WIDTH + D_MODEL]
    h = x
    for l in range(DEPTH):
        u = rms_norm(h, norm_mix[l])
        proj = u @ w_in[l]
        z_pool, q, k, v, g_pool, g_attn = jnp.split(proj, splits, axis=-1)
        y_pool = multiscale_pool(z_pool, w_pool_group[l], pool_scale[l]) @ w_pool_branch[l]
        y_attn = windowed_gqa(q, k, v, sink[l]) @ w_attn_branch[l]
        merged = jax.nn.sigmoid(g_pool) * y_pool + jax.nn.sigmoid(g_attn) * y_attn
        h = h + merged @ w_out[l]
        u = rms_norm(h, norm_ffn[l])
        h = h + (jax.nn.silu(u @ w_ffn_gate[l]) * (u @ w_ffn_up[l])) @ w_ffn_down[l]
    return rms_norm(h, norm_final)
```

```cpp
#include <hip/hip_runtime.h>
#include <cstdio>
#include <cstdint>

#ifndef MK_N_LAUNCHES
#define MK_N_LAUNCHES 1
#endif

namespace pg8 {
#define PG8_LAS __attribute__((address_space(3)))
typedef unsigned short bf16_t;
typedef short bf16x8 __attribute__((ext_vector_type(8)));
typedef float f32x4 __attribute__((ext_vector_type(4)));
typedef unsigned u32x4 __attribute__((ext_vector_type(4)));
constexpr int BM = 256, BK = 64, HALF = 128, HTB = HALF * BK * 2  , STAGE_BYTES = 8 * HTB, NXCD = 8, WGM = 8;

__host__ __device__ __forceinline__ int lds_byte(int r, int c) { const int st = (r >> 4) * 2 + (c >> 5), rr = r & 15, cc = c & 31, ob = rr * 64 + cc * 2; return st * 1024 + (ob ^ (((ob >> 9) & 1) << 5)); }
__host__ __device__ __forceinline__ void stage_rc(int b, int& R, int& C) { const int st = b / 1024, sb = b % 1024, swz = sb ^ (((sb >> 9) & 1) << 5); R = (st >> 1) * 16 + swz / 64; C = (st & 1) * 32 + (swz % 64) / 2; }
__host__ __device__ __forceinline__ int perm32(int rho) { const int n = rho >> 4, i = rho & 15; return 8 * (i >> 2) + 4 * n + (i & 3); }

struct Unit { int pm, pn, seg; };
struct Gemm { const bf16_t* A; const bf16_t* Bt; int ld, ldb, K; };

struct StaticOrder {
    int nM, nN, nwg, G, c, nseg;
    __device__ void init(int M, int N, int G_, int c_, int nseg_) { nM = M / BM; nN = N / BM; nwg = nM * nN; G = G_; c = c_; nseg = nseg_; }
    __device__ bool next(int i, Unit& u) const {
        const int ui = i / nseg; u.seg = i - ui * nseg;
        const int L = ui * G + c; if (L >= nwg) return false;
        int wgid = L; { const int q = nwg / NXCD, r = nwg % NXCD, xcd = wgid % NXCD, off = wgid / NXCD; wgid = (xcd < r ? xcd * (q + 1) : r * (q + 1) + (xcd - r) * q) + off; }
        const int nig = WGM * nN, gid = wgid / nig, fm = gid * WGM, gsz = (nM - fm) < WGM ? (nM - fm) : WGM;
        u.pm = fm + ((wgid % nig) % gsz); u.pn = (wgid % nig) / gsz; return true;
    }
};

typedef float f32x2c __attribute__((ext_vector_type(2))); typedef __bf16 bf16x2c __attribute__((ext_vector_type(2)));
__device__ __forceinline__ unsigned cvt_pk_bf16(float lo, float hi) { f32x2c v = {lo, hi}; bf16x2c b = __builtin_convertvector(v, bf16x2c); return __builtin_bit_cast(unsigned, b); }
__device__ __forceinline__ float bf_lo(unsigned w) { return __uint_as_float(w << 16); }
__device__ __forceinline__ float bf_hi(unsigned w) { return __uint_as_float(w & 0xffff0000u); }
__device__ __forceinline__ float sigmoidf_fast(float v) { return __builtin_amdgcn_rcpf(1.0f + __builtin_amdgcn_exp2f(-1.4426950408889634f * v)); }

constexpr float RMS_EPS = 1e-6f;
__device__ __forceinline__ float row_ssq(const float* ssq, int np, int row, int pstride) {
    if (np == 1) return ssq[row];
    const f32x4* q = (const f32x4*)(ssq + (size_t)(row >> 8) * pstride + (row & 255) * 16);
    const f32x4 a = q[0], b = q[1], c = q[2], d = q[3];
    return (((a[0] + a[1]) + (a[2] + a[3])) + ((b[0] + b[1]) + (b[2] + b[3]))) + (((c[0] + c[1]) + (c[2] + c[3])) + ((d[0] + d[1]) + (d[2] + d[3])));
}
constexpr float QSCALE = 0.125f * 1.4426950408889634f;


struct EpiProj {
    static constexpr bool PERM = true, AFTER_DRAIN = false;
    bf16_t* O; const PG8_LAS float* rtab;
    __device__ __forceinline__ void operator()(f32x4 (&acc)[2][2][4][2], const Unit& u, int wr, int wc, int fr, int fq) const {
        const int row0 = u.pm * BM + wr * 64 + fr, cin = wc * 32 + 8 * fq;
        const bool isq = (u.pn == 2 || u.pn == 3), isg = (u.pn >= 5);
#pragma unroll
        for (int ai = 0; ai < 2; ++ai)
#pragma unroll
            for (int m = 0; m < 4; ++m) {
                const int row = row0 + ai * HALF + m * 16;
                float rs = rtab[wr * 64 + fr + ai * HALF + m * 16]; if (isq) rs *= QSCALE;
                bf16_t* rowp = O + (size_t)row * 3328;
                if (!isg) {
#pragma unroll
                    for (int bj = 0; bj < 2; ++bj) {
                        const f32x4 v0 = acc[ai][bj][m][0] * rs, v1 = acc[ai][bj][m][1] * rs;
                        u32x4 w; w.x = cvt_pk_bf16(v0[0], v0[1]); w.y = cvt_pk_bf16(v0[2], v0[3]); w.z = cvt_pk_bf16(v1[0], v1[1]); w.w = cvt_pk_bf16(v1[2], v1[3]);
                        *(u32x4*)(rowp + u.pn * BM + bj * HALF + cin) = w;
                    }
                } else {
                    const float nl = -1.4426950408889634f * rs;
                    f32x4 r0, r1, s0, s1;
#pragma unroll
                    for (int e = 0; e < 4; ++e) {
                        const float ep0 = __builtin_amdgcn_exp2f(acc[ai][0][m][0][e] * nl), ea0 = __builtin_amdgcn_exp2f(acc[ai][1][m][0][e] * nl);
                        const float ep1 = __builtin_amdgcn_exp2f(acc[ai][0][m][1][e] * nl), ea1 = __builtin_amdgcn_exp2f(acc[ai][1][m][1][e] * nl);
                        s0[e] = __builtin_amdgcn_rcpf(1.0f + ea0); s1[e] = __builtin_amdgcn_rcpf(1.0f + ea1);
                        r0[e] = (1.0f + ea0) * __builtin_amdgcn_rcpf(1.0f + ep0); r1[e] = (1.0f + ea1) * __builtin_amdgcn_rcpf(1.0f + ep1);
                    }
                    const int j = (u.pn - 5) * HALF + cin;
                    u32x4 w; w.x = cvt_pk_bf16(r0[0], r0[1]); w.y = cvt_pk_bf16(r0[2], r0[3]); w.z = cvt_pk_bf16(r1[0], r1[1]); w.w = cvt_pk_bf16(r1[2], r1[3]);
                    *(u32x4*)(rowp + 1280 + j) = w;
                    w.x = cvt_pk_bf16(s0[0], s0[1]); w.y = cvt_pk_bf16(s0[2], s0[3]); w.z = cvt_pk_bf16(s1[0], s1[1]); w.w = cvt_pk_bf16(s1[2], s1[3]);
                    *(u32x4*)(rowp + 2304 + j) = w;
                }
                __builtin_amdgcn_sched_barrier(0);
            }
    }
};

struct EpiMerge {
    static constexpr bool PERM = true, AFTER_DRAIN = false;
    const bf16_t* P; bf16_t* O;
    __device__ __forceinline__ void operator()(f32x4 (&acc)[2][2][4][2], const Unit& u, int wr, int wc, int fr, int fq) const {
        const int row0 = u.pm * BM + wr * 64 + fr, col0 = u.pn * BM + wc * 32 + 8 * fq;
        const int gcol = (u.seg == 0 ? 1280 : 2304) + col0;
#pragma unroll
        for (int ai = 0; ai < 2; ++ai) {
            u32x4 ga[4][2];
#pragma unroll
            for (int m = 0; m < 4; ++m)
#pragma unroll
                for (int bj = 0; bj < 2; ++bj) ga[m][bj] = *(const u32x4*)(P + (size_t)(row0 + ai * HALF + m * 16) * 3328 + gcol + bj * HALF);
#pragma unroll
            for (int m = 0; m < 4; ++m)
#pragma unroll
                for (int bj = 0; bj < 2; ++bj) {
                    const u32x4 g = ga[m][bj];
                    const f32x4 a0 = (f32x4){bf_lo(g.x), bf_hi(g.x), bf_lo(g.y), bf_hi(g.y)}, a1 = (f32x4){bf_lo(g.z), bf_hi(g.z), bf_lo(g.w), bf_hi(g.w)};
                    acc[ai][bj][m][0] *= a0; acc[ai][bj][m][1] *= a1;
                    if (u.seg != 0) {
                        const f32x4 v0 = acc[ai][bj][m][0], v1 = acc[ai][bj][m][1];
                        u32x4 w; w.x = cvt_pk_bf16(v0[0], v0[1]); w.y = cvt_pk_bf16(v0[2], v0[3]); w.z = cvt_pk_bf16(v1[0], v1[1]); w.w = cvt_pk_bf16(v1[2], v1[3]);
                        *(u32x4*)(O + (size_t)(row0 + ai * HALF + m * 16) * 1024 + col0 + bj * HALF) = w;
                    }
                }
        }
    }
};

struct EpiResid {
    static constexpr bool PERM = true, AFTER_DRAIN = false;
    const bf16_t* baseh; bf16_t* outh; float* ssq; int pstride;
    __device__ __forceinline__ void operator()(f32x4 (&acc)[2][2][4][2], const Unit& u, int wr, int wc, int fr, int fq) const {
        const int row0 = u.pm * BM + wr * 64 + fr, col0 = u.pn * BM + wc * 32 + 8 * fq;
#pragma unroll
        for (int ai = 0; ai < 2; ++ai) {
            u32x4 bb[4][2];
#pragma unroll
            for (int m = 0; m < 4; ++m)
#pragma unroll
                for (int bj = 0; bj < 2; ++bj) bb[m][bj] = *(const u32x4*)(baseh + (size_t)(row0 + ai * HALF + m * 16) * 1024 + col0 + bj * HALF);
#pragma unroll
            for (int m = 0; m < 4; ++m) {
                const int row = row0 + ai * HALF + m * 16; float s = 0.f;
#pragma unroll
                for (int bj = 0; bj < 2; ++bj) {
                    const u32x4 b = bb[m][bj];
                    const f32x4 v0 = acc[ai][bj][m][0] + (f32x4){bf_lo(b.x), bf_hi(b.x), bf_lo(b.y), bf_hi(b.y)}, v1 = acc[ai][bj][m][1] + (f32x4){bf_lo(b.z), bf_hi(b.z), bf_lo(b.w), bf_hi(b.w)};
                    s += (v0[0] * v0[0] + v0[1] * v0[1]) + (v0[2] * v0[2] + v0[3] * v0[3]) + (v1[0] * v1[0] + v1[1] * v1[1]) + (v1[2] * v1[2] + v1[3] * v1[3]);
                    u32x4 w; w.x = cvt_pk_bf16(v0[0], v0[1]); w.y = cvt_pk_bf16(v0[2], v0[3]); w.z = cvt_pk_bf16(v1[0], v1[1]); w.w = cvt_pk_bf16(v1[2], v1[3]);
                    *(u32x4*)(outh + (size_t)row * 1024 + col0 + bj * HALF) = w;
                }
                s += __shfl_xor(s, 16); s += __shfl_xor(s, 32);
                if (fq == 0) ssq[(size_t)(row >> 8) * pstride + (row & 255) * 16 + u.pn * 4 + wc] = s;
            }
        }
    }
};

struct EpiSwiglu {
    static constexpr bool PERM = true, AFTER_DRAIN = false;
    bf16_t* O; const PG8_LAS float* rtab;
    __device__ __forceinline__ void operator()(f32x4 (&acc)[2][2][4][2], const Unit& u, int wr, int wc, int fr, int fq) const {
        const int row0 = u.pm * BM + wr * 64 + fr, col0 = u.pn * HALF + wc * 32 + 8 * fq;
#pragma unroll
        for (int ai = 0; ai < 2; ++ai)
#pragma unroll
            for (int m = 0; m < 4; ++m) {
                const int row = row0 + ai * HALF + m * 16;
                const float rs = rtab[wr * 64 + fr + ai * HALF + m * 16];
                f32x4 o[2];
#pragma unroll
                for (int n = 0; n < 2; ++n) {
                    const f32x4 g = acc[ai][0][m][n] * rs, up = acc[ai][1][m][n] * rs;
#pragma unroll
                    for (int e = 0; e < 4; ++e) o[n][e] = g[e] * sigmoidf_fast(g[e]) * up[e];
                }
                u32x4 w; w.x = cvt_pk_bf16(o[0][0], o[0][1]); w.y = cvt_pk_bf16(o[0][2], o[0][3]); w.z = cvt_pk_bf16(o[1][0], o[1][1]); w.w = cvt_pk_bf16(o[1][2], o[1][3]);
                *(u32x4*)(O + (size_t)row * 3328 + col0) = w;
            }
    }
};

template <class Epi, class Sched, bool ALIGN_EPI = false, bool SP2 = false>
__device__ __forceinline__ void gemm_phase(PG8_LAS unsigned char* lds, const Gemm g, const Sched& S, const Epi& E) {
    int tid_o = threadIdx.x; asm volatile("" : "+v"(tid_o));
    const int tid = tid_o, wid = __builtin_amdgcn_readfirstlane(tid >> 6), lane = tid & 63, wr = wid >> 2, wc = wid & 3, fr = lane & 15, fq = lane >> 4;
    const int K = g.K, nt = K / BK, ld = g.ld, ldb = g.ldb;
    unsigned voffA[2], voffB[2];
#pragma unroll
    for (int i = 0; i < 2; ++i) { int R, C; stage_rc(tid * 16 + i * 8192, R, C); const int Rb = Epi::PERM ? ((R & ~31) + perm32(R & 31)) : R;
        voffA[i] = (unsigned)(R * ld + C) * 2u; voffB[i] = (unsigned)(Rb * ldb + C) * 2u; }
    const unsigned kstep = (unsigned)(BK * 2);
    const unsigned hstep = (unsigned)HALF * (unsigned)ld * 2u;
    const unsigned tstep = 2u * hstep;
    const unsigned hstepB = (unsigned)HALF * (unsigned)ldb * 2u, tstepB = 2u * hstepB;
    const unsigned ldsw = (unsigned)wid * 1024u;
    const int aoff = lds_byte(wr * 64 + fr, fq * 8), boff = lds_byte(wc * 32 + fr, fq * 8);
#define PG8_SA(b, h) (((b) * 2 + (h)) * HTB)
#define PG8_SB(b, h) ((4 + (b) * 2 + (h)) * HTB)
#define PG8_STAGE(bufoff, gbase, voff) do { _Pragma("unroll") for (int _i = 0; _i < 2; ++_i) \
        __builtin_amdgcn_global_load_lds((const unsigned*)((const char*)(gbase) + (voff)[_i]), (PG8_LAS unsigned*)(lds + (bufoff) + ldsw + _i * 8192), 16, 0, 0); } while (0)
#define PG8_LDA(dst, b, h) do { _Pragma("unroll") for (int m = 0; m < 4; ++m) _Pragma("unroll") for (int k = 0; k < 2; ++k) dst[m][k] = *(const PG8_LAS bf16x8*)(lds + PG8_SA(b, h) + aoff + m * 2048 + k * 1024); } while (0)
#define PG8_LDB(dst, b, h) do { _Pragma("unroll") for (int n = 0; n < 2; ++n) _Pragma("unroll") for (int k = 0; k < 2; ++k) dst[n][k] = *(const PG8_LAS bf16x8*)(lds + PG8_SB(b, h) + boff + n * 2048 + k * 1024); } while (0)
#define PG8_MMA(ai, bj, At, Bt) do { __builtin_amdgcn_s_setprio(1); _Pragma("unroll") for (int m = 0; m < 4; ++m) _Pragma("unroll") for (int n = 0; n < 2; ++n) _Pragma("unroll") for (int k = 0; k < 2; ++k) \
        acc[ai][bj][m][n] = __builtin_amdgcn_mfma_f32_16x16x32_bf16(Bt[n][k], At[m][k], acc[ai][bj][m][n], 0, 0, 0); __builtin_amdgcn_s_setprio(0); } while (0)
#define PG8_WAIT_V(n) asm volatile("s_waitcnt vmcnt(" #n ")" ::: "memory")
#define PG8_WAIT_L(n) asm volatile("s_waitcnt lgkmcnt(" #n ")" ::: "memory")
#define PG8_BAR __builtin_amdgcn_s_barrier()
#define PG8_SCHED __builtin_amdgcn_sched_barrier(0)
    Unit cur, nxt; int ui = 0;
    if (!S.next(0, cur)) return;
    f32x4 acc[2][2][4][2];
#pragma unroll
    for (int a = 0; a < 2; ++a)
#pragma unroll
        for (int b = 0; b < 2; ++b)
#pragma unroll
            for (int m = 0; m < 4; ++m)
#pragma unroll
                for (int n = 0; n < 2; ++n) acc[a][b][m][n] = (f32x4){0.f, 0.f, 0.f, 0.f};
    bf16x8 At[4][2], B0[2][2], B1[2][2];
    const char* cA = (const char*)g.A + (size_t)cur.pm * tstep + (size_t)cur.seg * K * 2; const char* cB = (const char*)g.Bt + (size_t)cur.pn * tstepB + (size_t)cur.seg * K * 2;
    if constexpr (SP2) {
        PG8_STAGE(PG8_SB(0, 0), cB, voffB); PG8_STAGE(PG8_SB(0, 1), cB + hstepB, voffB); PG8_STAGE(PG8_SA(0, 0), cA, voffA); PG8_STAGE(PG8_SA(0, 1), cA + hstep, voffA);
        if (wr == 1) PG8_BAR;
        PG8_WAIT_V(2); PG8_BAR;
        PG8_STAGE(PG8_SB(1, 0), cB + kstep, voffB); PG8_STAGE(PG8_SA(1, 0), cA + kstep, voffA); PG8_STAGE(PG8_SB(1, 1), cB + hstepB + kstep, voffB);
        PG8_WAIT_V(6); PG8_BAR;
    } else {
        PG8_STAGE(PG8_SB(0, 0), cB, voffB); PG8_STAGE(PG8_SA(0, 0), cA, voffA); PG8_STAGE(PG8_SB(0, 1), cB + hstepB, voffB); PG8_STAGE(PG8_SA(0, 1), cA + hstep, voffA);
        if (wr == 1) PG8_BAR;
        PG8_WAIT_V(4); PG8_BAR;
        PG8_STAGE(PG8_SB(1, 0), cB + kstep, voffB); PG8_STAGE(PG8_SA(1, 0), cA + kstep, voffA); PG8_STAGE(PG8_SB(1, 1), cB + hstepB + kstep, voffB);
        PG8_WAIT_V(6); PG8_BAR;
    }
    for (;;) {
        const bool has_next = S.next(ui + 1, nxt);
        const char* nA = has_next ? (const char*)g.A + (size_t)nxt.pm * tstep + (size_t)nxt.seg * K * 2 : cA; const char* nB = has_next ? (const char*)g.Bt + (size_t)nxt.pn * tstepB + (size_t)nxt.seg * K * 2 : cB;
        for (int t = 0; t < nt; t += 2) {
            const bool last = (t == nt - 2);
            const char* a1 = cA + (size_t)(t + 1) * kstep;
            const char* a2 = last ? nA : cA + (size_t)(t + 2) * kstep; const char* b2 = last ? nB : cB + (size_t)(t + 2) * kstep;
            const char* a3 = a2 + kstep; const char* b3 = b2 + kstep;
            if constexpr (SP2) {
            PG8_LDB(B0, 0, 0); PG8_LDB(B1, 0, 1); PG8_SCHED; PG8_LDA(At, 0, 0); PG8_STAGE(PG8_SA(1, 1), a1 + hstep, voffA);
            PG8_WAIT_V(8); PG8_WAIT_L(0); PG8_BAR; PG8_MMA(0, 0, At, B0); PG8_MMA(0, 1, At, B1); PG8_BAR; PG8_SCHED;
            PG8_LDA(At, 0, 1); PG8_STAGE(PG8_SB(0, 0), b2, voffB); PG8_STAGE(PG8_SB(0, 1), b2 + hstepB, voffB); PG8_STAGE(PG8_SA(0, 0), a2, voffA);
            PG8_WAIT_V(8); PG8_WAIT_L(0); PG8_BAR; PG8_MMA(1, 0, At, B0); PG8_MMA(1, 1, At, B1); PG8_BAR; PG8_SCHED;
            PG8_LDB(B0, 1, 0); PG8_LDB(B1, 1, 1); PG8_SCHED; PG8_LDA(At, 1, 0); PG8_STAGE(PG8_SA(0, 1), a2 + hstep, voffA);
            PG8_WAIT_V(8); PG8_WAIT_L(0); PG8_BAR; PG8_MMA(0, 0, At, B0); PG8_MMA(0, 1, At, B1); PG8_BAR; PG8_SCHED;
            PG8_LDA(At, 1, 1); PG8_STAGE(PG8_SB(1, 0), b3, voffB); PG8_STAGE(PG8_SB(1, 1), b3 + hstepB, voffB); PG8_STAGE(PG8_SA(1, 0), a3, voffA);
            PG8_WAIT_V(8); PG8_WAIT_L(0); PG8_BAR; PG8_MMA(1, 0, At, B0); PG8_MMA(1, 1, At, B1); PG8_BAR; PG8_SCHED;
            } else {
            PG8_LDB(B0, 0, 0); PG8_SCHED; PG8_LDA(At, 0, 0); PG8_STAGE(PG8_SA(1, 1), a1 + hstep, voffA);
            PG8_WAIT_L(8); PG8_BAR; PG8_WAIT_L(0); PG8_MMA(0, 0, At, B0); PG8_BAR; PG8_SCHED;
            PG8_LDB(B1, 0, 1); PG8_STAGE(PG8_SB(0, 0), b2, voffB);
            PG8_BAR; PG8_WAIT_L(0); PG8_MMA(0, 1, At, B1); PG8_BAR;
            PG8_LDA(At, 0, 1); PG8_STAGE(PG8_SA(0, 0), a2, voffA);
            PG8_BAR; PG8_WAIT_L(0); PG8_MMA(1, 0, At, B0); PG8_BAR; PG8_SCHED;
            PG8_STAGE(PG8_SB(0, 1), b2 + hstepB, voffB);
            PG8_WAIT_V(6); PG8_BAR; PG8_MMA(1, 1, At, B1); PG8_BAR;
            PG8_LDB(B0, 1, 0); PG8_SCHED; PG8_LDA(At, 1, 0); PG8_STAGE(PG8_SA(0, 1), a2 + hstep, voffA);
            PG8_WAIT_L(8); PG8_BAR; PG8_WAIT_L(0); PG8_MMA(0, 0, At, B0); PG8_BAR; PG8_SCHED;
            PG8_LDB(B1, 1, 1); PG8_STAGE(PG8_SB(1, 0), b3, voffB);
            PG8_BAR; PG8_WAIT_L(0); PG8_MMA(0, 1, At, B1); PG8_BAR;
            PG8_LDA(At, 1, 1); PG8_STAGE(PG8_SA(1, 0), a3, voffA);
            PG8_BAR; PG8_WAIT_L(0); PG8_MMA(1, 0, At, B0); PG8_BAR; PG8_SCHED;
            PG8_STAGE(PG8_SB(1, 1), b3 + hstepB, voffB);
            PG8_WAIT_V(6); PG8_BAR; PG8_MMA(1, 1, At, B1); PG8_BAR;
            }
        }
        if constexpr (ALIGN_EPI) { if (wr == 0) PG8_BAR; }
        E(acc, cur, wr, wc, fr, fq);
        if (!has_next) break;
        if (nxt.seg == 0) {
#pragma unroll
        for (int a = 0; a < 2; ++a)
#pragma unroll
            for (int b = 0; b < 2; ++b)
#pragma unroll
                for (int m = 0; m < 4; ++m)
#pragma unroll
                    for (int n = 0; n < 2; ++n) acc[a][b][m][n] = (f32x4){0.f, 0.f, 0.f, 0.f};
        }
        cur = nxt; cA = nA; cB = nB; ++ui;
        if constexpr (ALIGN_EPI) { if (wr == 1) PG8_BAR; }
    }
    PG8_WAIT_V(0);
    if constexpr (!ALIGN_EPI) { if (wr == 0) PG8_BAR; }
    PG8_BAR;
#undef PG8_SA
#undef PG8_SB
#undef PG8_STAGE
#undef PG8_LDA
#undef PG8_LDB
#undef PG8_MMA
#undef PG8_WAIT_V
#undef PG8_WAIT_L
#undef PG8_BAR
#undef PG8_SCHED
}
}

constexpr int NWAVES = 8;
constexpr int DM = 1024, BATCH = 4, SEQ = 4096, DEPTH = 2, M = BATCH * SEQ;
constexpr int INW = 3328, DFF = 2816, NGU = 2 * DFF, POOLW = 512;
constexpr float LOG2E = 1.4426950408889634f;
constexpr int N_LAUNCHES = MK_N_LAUNCHES;
constexpr int N_PHASES = 2 + 6 * DEPTH;

constexpr size_t MiB = 1u << 20;
constexpr size_t WS_CTL = 0, CTL_ZERO_BYTES = 1 * MiB;
constexpr size_t WS_W = 2 * MiB, W_LAYER = 27 * MiB;
constexpr size_t WO_IN = 0, WO_PA = 13 * MiB / 2, WO_OUT = WO_PA + 2 * MiB, WO_GU = WO_OUT + 2 * MiB, WO_D = WO_GU + 11 * MiB;
static_assert(WO_D + (size_t)DM * DFF * 2 <= W_LAYER, "weight map");
constexpr size_t WS_HB = 56 * MiB;
constexpr size_t WS_MG = 88 * MiB;
constexpr size_t WS_PROJ = 120 * MiB;
constexpr size_t WS_DA = 224 * MiB;
constexpr size_t WS_END = 256 * MiB;
static_assert(WS_W + DEPTH * W_LAYER <= WS_HB && WS_PROJ + (size_t)M * INW * 2 <= WS_DA && WS_DA + (size_t)M * DM * 2 <= WS_END, "d_ws map");
constexpr int CW_BAR = 4096;
constexpr int CW_BAR2 = 8192;
constexpr int CW_PBD = 20480;
constexpr int CW_XCCTAB = 16384;
constexpr int CW_SSQ = 131072;
static_assert((CW_SSQ + M) * 4 <= (int)CTL_ZERO_BYTES && WS_CTL + CTL_ZERO_BYTES + (size_t)M * 16 * 4 <= 2 * MiB, "ctl map");

constexpr int RING_OFF = 0, RING_BYTES = 135168;
constexpr int LDSCTL_OFF = RING_BYTES, MISC_OFF = LDSCTL_OFF + 320;
constexpr int LDS_BYTES = 147456;
static_assert(MISC_OFF + 128 <= LDSCTL_OFF + 1024 && LDSCTL_OFF + 1024 + 1024 <= LDS_BYTES, "LDS map: control words, then the 1 KiB rstd table");

#define GAS __attribute__((address_space(1)))
#define LAS __attribute__((address_space(3)))
typedef unsigned short bf16;
typedef unsigned v4u __attribute__((ext_vector_type(4)));
typedef unsigned v2u __attribute__((ext_vector_type(2)));
typedef float f32x4 __attribute__((ext_vector_type(4)));
typedef float f32x16 __attribute__((ext_vector_type(16)));
typedef short bf16x8 __attribute__((ext_vector_type(8)));
typedef short s16x4 __attribute__((ext_vector_type(4)));
#define LDS_WAIT() asm volatile("s_waitcnt lgkmcnt(0)" ::: "memory")
#define VM_WAIT() asm volatile("s_waitcnt vmcnt(0)" ::: "memory")
__device__ __forceinline__ unsigned f2bf(float f) { unsigned u = __builtin_bit_cast(unsigned, f); return (u + 0x7fffu + ((u >> 16) & 1u)) >> 16; }
typedef float f32x2p __attribute__((ext_vector_type(2))); typedef __bf16 bf16x2p __attribute__((ext_vector_type(2)));
__device__ __forceinline__ unsigned pk2(float lo, float hi) { f32x2p v = {lo, hi}; bf16x2p b = __builtin_convertvector(v, bf16x2p); return __builtin_bit_cast(unsigned, b); }
__device__ __forceinline__ float bflo(unsigned w) { return __uint_as_float(w << 16); }
__device__ __forceinline__ float bfhi(unsigned w) { return __uint_as_float(w & 0xffff0000u); }

#define XB_TMO      128
#define XB_XCNT(j)  (256  + 64 * (j))
#define XB_XSUB(j)  (1280 + 64 * (j))
#define XB_XGEN(j)  (2304 + 64 * (j))
#define XB_TOP      3328
#define XB_TOPGEN   3392
#define XCD_BAR_WORDS 3456
#define XB_SPIN_CAP (1u << 18)

__device__ __forceinline__ unsigned xb_ld(unsigned* p)              { return __hip_atomic_load(p, __ATOMIC_RELAXED, __HIP_MEMORY_SCOPE_AGENT); }
__device__ __forceinline__ unsigned xb_add(unsigned* p, unsigned v) { return __hip_atomic_fetch_add(p, v, __ATOMIC_RELAXED, __HIP_MEMORY_SCOPE_AGENT); }
__device__ __forceinline__ unsigned xb_xcc_id() { return (unsigned)__builtin_amdgcn_s_getreg((3 << 11) | 20) & 0xFu; }
#define XB_SPIN(cond, bar) do { unsigned _sp = 0; while (cond) { __builtin_amdgcn_s_sleep(1); \
    if ((++_sp & 255u) == 0u) { if (xb_ld(&(bar)[XB_TMO])) break; if (_sp > XB_SPIN_CAP) { atomicAdd(&(bar)[XB_TMO], 1u); break; } } } } while (0)

struct XcdBarrier {
    unsigned* bar; unsigned x;
    volatile LAS unsigned* st;
};

__device__ __forceinline__ XcdBarrier xcd_barrier_post(unsigned* bar, volatile LAS unsigned* st) {
    XcdBarrier b; b.bar = bar; b.x = xb_xcc_id(); b.st = st;
    if (threadIdx.x == 0) (void)xb_add(&bar[XB_XCNT(b.x)], 1u);
    return b;
}
__device__ __forceinline__ void xcd_barrier_complete(unsigned* bar, unsigned x, unsigned& nloc, unsigned& nx) {
    const unsigned G = gridDim.x * gridDim.y * gridDim.z;
    unsigned sum, cnt, mine, sp = 0u;
    for (;;) {
        sum = 0u; cnt = 0u; mine = 0u;
#pragma unroll
        for (unsigned j = 0; j < 16; ++j) { const unsigned c = xb_ld(&bar[XB_XCNT(j)]); sum += c; cnt += (c > 0u) ? 1u : 0u; mine = (j == x) ? c : mine; }
        if (sum == G) break;
        __builtin_amdgcn_s_sleep(1);
        if ((++sp & 255u) == 0u) { if (xb_ld(&bar[XB_TMO])) break; if (sp > XB_SPIN_CAP) { atomicAdd(&bar[XB_TMO], 1u); break; } }
    }
    nloc = mine > 0u ? mine : 1u; nx = cnt > 0u ? cnt : 1u;
}

__device__ __forceinline__ void xcd_barrier(const XcdBarrier& b) {
    asm volatile("s_waitcnt vmcnt(0)" ::: "memory");
    __syncthreads();
    if (threadIdx.x == 0) {
        unsigned* bar = b.bar;
        __builtin_amdgcn_s_waitcnt(0);
        unsigned nloc = b.st[0], nx = b.st[1];
        if (nloc == 0u) { xcd_barrier_complete(bar, b.x, nloc, nx); b.st[0] = nloc; b.st[1] = nx; }
        const unsigned old = xb_add(&bar[XB_XSUB(b.x)], 1u);
        const unsigned gen = old / nloc;
        if (old + 1u == (gen + 1u) * nloc) {
            __builtin_amdgcn_fence(__ATOMIC_RELEASE, "agent");
            asm volatile("s_waitcnt vmcnt(0)" ::: "memory");
            const unsigned og = xb_add(&bar[XB_TOP], 1u);
            const unsigned tg = og / nx;
            if (og + 1u == (tg + 1u) * nx) xb_add(&bar[XB_TOPGEN], 1u);
            else XB_SPIN(xb_ld(&bar[XB_TOPGEN]) == tg, bar);
            __builtin_amdgcn_fence(__ATOMIC_ACQUIRE, "agent");
            xb_add(&bar[XB_XGEN(b.x)], 1u);
            asm volatile("s_waitcnt vmcnt(0)" ::: "memory");
        } else {
            XB_SPIN(xb_ld(&bar[XB_XGEN(b.x)]) == gen, bar);
            __builtin_amdgcn_fence(__ATOMIC_ACQUIRE, "agent");
            asm volatile("s_waitcnt vmcnt(0)" ::: "memory");
        }
    }
    __syncthreads();
}

__device__ __forceinline__ float wave_sum(float v) {
#pragma unroll
    for (int o = 1; o < 64; o <<= 1) v += __shfl_xor(v, o);
    return v;
}
constexpr int TR_PITCH = 65, TR_SCR_BYTES = 64 * TR_PITCH * 4;
template <int GU>
__device__ __forceinline__ void p0_transpose_item(const float* W, int N, const float* kscale, bf16* WT, int ldt, int koff, LAS float* scr, int item, int lane) {
    const int nblk = N / 64, kb = item / nblk, nb = item % nblk, k0 = 64 * kb, n0 = 64 * nb;
    const int q = lane >> 4, cc = lane & 15;
    f32x4 v[16];
#pragma unroll
    for (int i = 0; i < 16; ++i) v[i] = *(const GAS f32x4*)(W + (size_t)(k0 + 4 * i + q) * N + n0 + 4 * cc);
    const int c = lane & 7;
    f32x4 s0 = (f32x4){1.f, 1.f, 1.f, 1.f}, s1 = s0;
    if (kscale) { s0 = *(const GAS f32x4*)(kscale + k0 + 8 * c); s1 = *(const GAS f32x4*)(kscale + k0 + 8 * c + 4); }
#pragma unroll
    for (int i = 0; i < 16; ++i) { LAS float* d = scr + (4 * i + q) * TR_PITCH + 4 * cc; d[0] = v[i].x; d[1] = v[i].y; d[2] = v[i].z; d[3] = v[i].w; }
    LDS_WAIT(); asm volatile("" ::: "memory");
#pragma unroll
    for (int j = 0; j < 8; ++j) { const int n = (lane >> 3) + 8 * j; const LAS float* s = scr + (8 * c) * TR_PITCH + n;
        v4u o; o.x = pk2(s[0 * TR_PITCH] * s0.x, s[1 * TR_PITCH] * s0.y); o.y = pk2(s[2 * TR_PITCH] * s0.z, s[3 * TR_PITCH] * s0.w);
        o.z = pk2(s[4 * TR_PITCH] * s1.x, s[5 * TR_PITCH] * s1.y); o.w = pk2(s[6 * TR_PITCH] * s1.z, s[7 * TR_PITCH] * s1.w);
        const int ng = n0 + n; int drow;
        if (GU == 0) drow = ng;
        else if (GU == 3) { const int gsel = (ng >= 2304) ? 1 : 0, j = ng - 1280 - 1024 * gsel; drow = (ng < 1280) ? ng : (1280 + 256 * (j >> 7) + 128 * gsel + (j & 127)); }
        else drow = 256 * (ng >> 7) + (GU - 1) * 128 + (ng & 127);
        *(GAS v4u*)(WT + (size_t)drow * ldt + koff + k0 + 8 * c) = o; }
    LDS_WAIT(); asm volatile("" ::: "memory");
}
__device__ __forceinline__ void p0_pooleff_item(const float* wg, const float* scale, const float* wpb, bf16* WT, int item, int lane) {
    const int nblk = item & 15, cblk = (item >> 4) & 15, g = item >> 8;
    const int n = nblk * 64 + lane;
    const float* wgp = wg + (size_t)(g * 128 + cblk * 8) * 128;
    const float* bp = wpb + (size_t)(g * 128) * 1024 + n;
    const float* sp = scale + g * 128;
    float a0 = 0.f, a1 = 0.f, a2 = 0.f, a3 = 0.f, a4 = 0.f, a5 = 0.f, a6 = 0.f, a7 = 0.f;
#pragma unroll 1
    for (int j0 = 0; j0 < 128; j0 += 16) {
        float b[16];
#pragma unroll
        for (int u = 0; u < 16; ++u) b[u] = bp[(size_t)(j0 + u) * 1024];
#pragma unroll
        for (int u = 0; u < 16; ++u) { const float bb = b[u] * sp[j0 + u];
            a0 += wgp[0 * 128 + j0 + u] * bb; a1 += wgp[1 * 128 + j0 + u] * bb; a2 += wgp[2 * 128 + j0 + u] * bb; a3 += wgp[3 * 128 + j0 + u] * bb;
            a4 += wgp[4 * 128 + j0 + u] * bb; a5 += wgp[5 * 128 + j0 + u] * bb; a6 += wgp[6 * 128 + j0 + u] * bb; a7 += wgp[7 * 128 + j0 + u] * bb; }
    }
    v4u o; o.x = pk2(a0, a1); o.y = pk2(a2, a3); o.z = pk2(a4, a5); o.w = pk2(a6, a7);
    *(GAS v4u*)(WT + (size_t)n * 1024 + g * 128 + cblk * 8) = o;
}
constexpr int I_P = 1024, I_IN = (DM / 64) * (INW / 64), I_A = (512 / 64) * (DM / 64), I_O = (DM / 64) * (DM / 64), I_G = (DM / 64) * (DFF / 64), I_D = (DFF / 64) * (DM / 64);
constexpr int I_LAYER = I_P + I_IN + I_A + I_O + 2 * I_G + I_D;
__device__ __forceinline__ void convert_layer_items(const float* const* in, unsigned char* ws, int l, int first, int stride, LAS float* scr, int lane, int mode) {
    unsigned char* wl = ws + WS_W + (size_t)l * W_LAYER;
    const int count = mode == 0 ? I_IN : (mode == 1 ? I_LAYER - I_IN : I_LAYER);
    for (int it = first; it < count; it += stride) {
        int r = mode == 0 ? it + I_P : (mode == 1 ? (it < I_P ? it : it + I_IN) : it);
        if (r < I_P) { p0_pooleff_item(in[3] + (size_t)l * 4 * 128 * 128, in[4] + (size_t)l * POOLW, in[6] + (size_t)l * POOLW * DM, (bf16*)(wl + WO_PA), r, lane); continue; } r -= I_P;
        if (r < I_IN) { p0_transpose_item<3>(in[2] + (size_t)l * DM * INW, INW, in[1] + (size_t)l * DM, (bf16*)(wl + WO_IN), DM, 0, scr, r, lane); continue; } r -= I_IN;
        if (r < I_A) { p0_transpose_item<0>(in[7] + (size_t)l * 512 * DM, DM, nullptr, (bf16*)(wl + WO_PA), DM, 512, scr, r, lane); continue; } r -= I_A;
        if (r < I_O) { p0_transpose_item<0>(in[8] + (size_t)l * DM * DM, DM, nullptr, (bf16*)(wl + WO_OUT), DM, 0, scr, r, lane); continue; } r -= I_O;
        if (r < I_G) { p0_transpose_item<1>(in[10] + (size_t)l * DM * DFF, DFF, in[9] + (size_t)l * DM, (bf16*)(wl + WO_GU), DM, 0, scr, r, lane); continue; } r -= I_G;
        if (r < I_G) { p0_transpose_item<2>(in[11] + (size_t)l * DM * DFF, DFF, in[9] + (size_t)l * DM, (bf16*)(wl + WO_GU), DM, 0, scr, r, lane); continue; } r -= I_G;
        p0_transpose_item<0>(in[12] + (size_t)l * DFF * DM, DM, nullptr, (bf16*)(wl + WO_D), DFF, 0, scr, r, lane);
    }
}

constexpr int KS_PITCH = 72, VT_PITCH = 388, KS_BYTES = 384 * KS_PITCH * 2;
static_assert(KS_BYTES % 16 == 0 && KS_BYTES + 64 * VT_PITCH * 2 <= RING_BYTES, "attention LDS");
__device__ __forceinline__ int crow(int r, int hi) { return (r & 3) + 8 * (r >> 2) + 4 * hi; }
typedef float f32x2_t __attribute__((ext_vector_type(2))); typedef __bf16 bf16x2_t __attribute__((ext_vector_type(2)));
__device__ __forceinline__ unsigned cvtpk_rne(float lo, float hi) { f32x2_t v = {lo, hi}; bf16x2_t b = __builtin_convertvector(v, bf16x2_t); return __builtin_bit_cast(unsigned, b); }
__device__ __forceinline__ void attn_unit(LAS unsigned char* lds, const bf16* PROJ, bf16* DA, const float* sinkl, int unit, int tid, int wid, int lane) {
    const int n = unit & 31, hk = (unit >> 5) & 1, b = unit >> 6;
    LAS bf16* Ks = (LAS bf16*)lds;
    LAS bf16* Vt = (LAS bf16*)(lds + KS_BYTES);
    const size_t rowb = (size_t)b * SEQ;
    const int s0 = (n - 1) * 128;
#pragma unroll
    for (int hp = 0; hp < 2; ++hp) {
        v4u kreg[3], vreg[3];
#pragma unroll
        for (int i = 0; i < 3; ++i) {
            const int idx = tid + 512 * (3 * hp + i), c = idx >> 3, ch = idx & 7, s = s0 + c;
            if (s >= 0 && s < SEQ) { const bf16* p = PROJ + (rowb + s) * INW + 1024 + hk * 64 + ch * 8; kreg[i] = *(const v4u*)p; vreg[i] = *(const v4u*)(p + 128); }
            else { kreg[i] = (v4u){0u, 0u, 0u, 0u}; vreg[i] = (v4u){0u, 0u, 0u, 0u}; }
        }
#pragma unroll
        for (int i = 0; i < 3; ++i) {
            const int idx = tid + 512 * (3 * hp + i), c = idx >> 3, ch = idx & 7;
            *(LAS v4u*)(Ks + c * KS_PITCH + ch * 8) = kreg[i];
            LAS bf16* vp = Vt + (ch * 8) * VT_PITCH + c;
            vp[0 * VT_PITCH] = (bf16)(vreg[i].x & 0xffffu); vp[1 * VT_PITCH] = (bf16)(vreg[i].x >> 16);
            vp[2 * VT_PITCH] = (bf16)(vreg[i].y & 0xffffu); vp[3 * VT_PITCH] = (bf16)(vreg[i].y >> 16);
            vp[4 * VT_PITCH] = (bf16)(vreg[i].z & 0xffffu); vp[5 * VT_PITCH] = (bf16)(vreg[i].z >> 16);
            vp[6 * VT_PITCH] = (bf16)(vreg[i].w & 0xffffu); vp[7 * VT_PITCH] = (bf16)(vreg[i].w >> 16);
        }
    }
    __syncthreads();
    const int r32 = lane & 31, hi = lane >> 5;
    const int hq = hk * 4 + (wid >> 1);
    const float slope2 = __builtin_amdgcn_exp2f(-(float)(hq + 1)) * LOG2E;
    const float sink2 = sinkl[hq] * LOG2E;
    const float NEG = -INFINITY;
    const bool edge_n = (n == 0) || (n == 31);
#pragma unroll 1
    for (int sb = 0; sb < 2; ++sb) {
        const int a0 = 64 * (wid & 1) + 32 * sb, a = a0 + r32;
        const size_t qrow = rowb + (size_t)n * 128 + a;
        bf16x8 qf[4];
#pragma unroll
        for (int ks = 0; ks < 4; ++ks) qf[ks] = *(const bf16x8*)(PROJ + qrow * INW + 512 + hq * 64 + ks * 16 + hi * 8);
        float mrun = sink2, l = 0.f;
        f32x16 o0, o1;
#pragma unroll
        for (int r = 0; r < 16; ++r) { o0[r] = 0.f; o1[r] = 0.f; }
        const float fb0 = (float)(r32 + 128 - 4 * hi);
        f32x16 pn;
#define ATT_QK(dst, cblk) do { _Pragma("unroll") for (int r = 0; r < 16; ++r) dst[r] = 0.f; \
            _Pragma("unroll") for (int ks = 0; ks < 4; ++ks) { const bf16x8 kf = *(const LAS bf16x8*)(Ks + ((cblk) + r32) * KS_PITCH + ks * 16 + hi * 8); \
                dst = __builtin_amdgcn_mfma_f32_32x32x16_bf16(kf, qf[ks], dst, 0, 0, 0); } } while (0)
        ATT_QK(pn, a0);
#pragma unroll 1
        for (int i = 0; i < 9; ++i) {
            const int c0 = a0 + 32 * i;
            f32x16 p = pn;
            if (i < 8) ATT_QK(pn, c0 + 32);
            const float fb = fb0 - (float)(32 * i);
            const int sb0 = s0 + c0 + 4 * hi;
            const float kmin = fmaxf(fb - 128.0f, (float)(-sb0)), kmax = fminf(fb + 128.0f, (float)(SEQ - 1 - sb0));
            const float kmid = 0.5f * (kmin + kmax), khw = 0.5f * (kmax - kmin);
            float mx = NEG;
#pragma unroll
            for (int r = 0; r < 16; ++r) { const float kr = (float)((r & 3) + 8 * (r >> 2)); p[r] = p[r] - slope2 * fabsf(fb - kr); }
            if ((i == 0) || (i == 8) || edge_n) {
#pragma unroll
                for (int r = 0; r < 16; ++r) { const float kr = (float)((r & 3) + 8 * (r >> 2)); p[r] = (fabsf(kr - kmid) <= khw) ? p[r] : NEG; }
            }
#pragma unroll
            for (int r = 0; r < 16; ++r) mx = fmaxf(mx, p[r]);
            { const auto rr = __builtin_amdgcn_permlane32_swap(__float_as_uint(mx), __float_as_uint(mx), false, false); mx = fmaxf(__uint_as_float(rr[0]), __uint_as_float(rr[1])); }
            if (__any(mx > mrun + 8.0f)) {
                const float mnew = fmaxf(mrun, mx), alpha = __builtin_amdgcn_exp2f(mrun - mnew);
                mrun = mnew; l *= alpha;
#pragma unroll
                for (int r = 0; r < 16; ++r) { o0[r] *= alpha; o1[r] *= alpha; }
            }
            float ps = 0.f;
#pragma unroll
            for (int r = 0; r < 16; ++r) { p[r] = __builtin_amdgcn_exp2f(p[r] - mrun); ps += p[r]; }
            l += ps;
#pragma unroll
            for (int s = 0; s < 2; ++s) {
                v4u pw; pw.x = pg8::cvt_pk_bf16(p[8 * s + 0], p[8 * s + 1]); pw.y = pg8::cvt_pk_bf16(p[8 * s + 2], p[8 * s + 3]);
                pw.z = pg8::cvt_pk_bf16(p[8 * s + 4], p[8 * s + 5]); pw.w = pg8::cvt_pk_bf16(p[8 * s + 6], p[8 * s + 7]);
                const bf16x8 pb = __builtin_bit_cast(bf16x8, pw);
#pragma unroll
                for (int db = 0; db < 2; ++db) {
                    const LAS bf16* vp = Vt + (db * 32 + r32) * VT_PITCH + c0 + 16 * s + 4 * hi;
                    const s16x4 vlo = *(const LAS s16x4*)vp, vhi = *(const LAS s16x4*)(vp + 8);
                    const bf16x8 vf = (bf16x8){vlo[0], vlo[1], vlo[2], vlo[3], vhi[0], vhi[1], vhi[2], vhi[3]};
                    if (db == 0) o0 = __builtin_amdgcn_mfma_f32_32x32x16_bf16(vf, pb, o0, 0, 0, 0);
                    else         o1 = __builtin_amdgcn_mfma_f32_32x32x16_bf16(vf, pb, o1, 0, 0, 0);
                }
            }
        }
#undef ATT_QK
        { const auto rr = __builtin_amdgcn_permlane32_swap(__float_as_uint(l), __float_as_uint(l), false, false); l = __uint_as_float(rr[0]) + __uint_as_float(rr[1]); }
        const float inv = 1.0f / (l + __builtin_amdgcn_exp2f(sink2 - mrun));
        bf16* orow = DA + qrow * 1024 + 512 + hq * 64;
#pragma unroll
        for (int db = 0; db < 2; ++db)
#pragma unroll
            for (int rp = 0; rp < 2; ++rp) {
                const f32x16& oo = db == 0 ? o0 : o1; const int ra = 8 * rp, rb = 8 * rp + 4;
                unsigned ax = cvtpk_rne(oo[ra] * inv, oo[ra + 1] * inv), ay = cvtpk_rne(oo[ra + 2] * inv, oo[ra + 3] * inv);
                unsigned bx = cvtpk_rne(oo[rb] * inv, oo[rb + 1] * inv), by = cvtpk_rne(oo[rb + 2] * inv, oo[rb + 3] * inv);
                { const auto t = __builtin_amdgcn_permlane32_swap(ax, bx, false, false); ax = t[0]; bx = t[1]; }
                { const auto t = __builtin_amdgcn_permlane32_swap(ay, by, false, false); ay = t[0]; by = t[1]; }
                *(v4u*)(orow + 32 * db + 16 * rp + 8 * hi) = (v4u){ax, ay, bx, by};
            }
    }
    __syncthreads();
}
__device__ __forceinline__ v4u sel4(int g, v4u a, v4u b, v4u c, v4u d) {
    v4u r; r.x = g == 0 ? a.x : (g == 1 ? b.x : (g == 2 ? c.x : d.x)); r.y = g == 0 ? a.y : (g == 1 ? b.y : (g == 2 ? c.y : d.y));
    r.z = g == 0 ? a.z : (g == 1 ? b.z : (g == 2 ? c.z : d.z)); r.w = g == 0 ? a.w : (g == 1 ? b.w : (g == 2 ? c.w : d.w)); return r;
}
__device__ __forceinline__ void pool_tokens8(const bf16* PROJ, bf16* DA, int t0, int lane) {
    const int sf = t0 & (SEQ - 1), g = lane >> 4, half = 1 << g;
    const bf16* zp = PROJ + (size_t)t0 * INW + lane * 8;
    v4u row[23];
#pragma unroll
    for (int ri = 0; ri < 23; ++ri) {
        const int off = ri - 8, sp = sf + off;
        row[ri] = (v4u){0u, 0u, 0u, 0u};
        if ((off >= -half) && (off < 7 + half) && (sp >= 0) && (sp < SEQ)) row[ri] = *(const v4u*)(zp + (ptrdiff_t)off * INW);
    }
    float S0 = 0.f, S1 = 0.f, S2 = 0.f, S3 = 0.f, S4 = 0.f, S5 = 0.f, S6 = 0.f, S7 = 0.f;
#pragma unroll
    for (int off = -8; off < 8; ++off) {
        const float w = (off >= -half && off < half) ? 1.f : 0.f; const v4u v = row[8 + off];
        S0 += w * bflo(v.x); S1 += w * bfhi(v.x); S2 += w * bflo(v.y); S3 += w * bfhi(v.y); S4 += w * bflo(v.z); S5 += w * bfhi(v.z); S6 += w * bflo(v.w); S7 += w * bfhi(v.w);
    }
#pragma unroll
    for (int j = 0; j < 8; ++j) {
        if (j > 0) {
            const v4u vi = sel4(g, row[8 + j - 1 + 1], row[8 + j - 1 + 2], row[8 + j - 1 + 4], row[8 + j - 1 + 8]);
            const v4u vo = sel4(g, row[8 + j - 1 - 1], row[8 + j - 1 - 2], row[8 + j - 1 - 4], row[8 + j - 1 - 8]);
            S0 += bflo(vi.x) - bflo(vo.x); S1 += bfhi(vi.x) - bfhi(vo.x); S2 += bflo(vi.y) - bflo(vo.y); S3 += bfhi(vi.y) - bfhi(vo.y);
            S4 += bflo(vi.z) - bflo(vo.z); S5 += bfhi(vi.z) - bfhi(vo.z); S6 += bflo(vi.w) - bflo(vo.w); S7 += bfhi(vi.w) - bfhi(vo.w);
        }
        const int s = sf + j, lo = (s - half) < 0 ? 0 : (s - half), hi = (s + half) > SEQ ? SEQ : (s + half);
        const float ic = 1.0f / (float)(hi - lo);
        const v4u zc = row[8 + j];
        v4u o; o.x = pk2(S0 * ic - bflo(zc.x), S1 * ic - bfhi(zc.x)); o.y = pk2(S2 * ic - bflo(zc.y), S3 * ic - bfhi(zc.y));
        o.z = pk2(S4 * ic - bflo(zc.z), S5 * ic - bfhi(zc.z)); o.w = pk2(S6 * ic - bflo(zc.w), S7 * ic - bfhi(zc.w));
        *(v4u*)(DA + (size_t)(t0 + j) * 1024 + lane * 8) = o;
    }
}

__device__ __forceinline__ void xcc_local_barrier(unsigned* bar2, unsigned x, unsigned nloc, unsigned* tmobar) {
    asm volatile("s_waitcnt vmcnt(0)" ::: "memory");
    __syncthreads();
    if (threadIdx.x == 0) {
        const unsigned old = xb_add(&bar2[XB_XSUB(x)], 1u);
        const unsigned gen = old / nloc;
        if (old + 1u == (gen + 1u) * nloc) (void)xb_add(&bar2[XB_XGEN(x)], 1u);
        else XB_SPIN(xb_ld(&bar2[XB_XGEN(x)]) == gen, tmobar);
        __builtin_amdgcn_fence(__ATOMIC_ACQUIRE, "agent");
        asm volatile("s_waitcnt vmcnt(0)" ::: "memory");
    }
    __syncthreads();
}

#ifndef DBG_MASK
#define DBG_MASK 255
#endif
#ifndef DBG_DOUBLE
#define DBG_DOUBLE 0
#endif
struct Args { const float* in[14]; float* out; unsigned char* ws; int ph_lo, ph_hi, li, pad; };
__global__ void __launch_bounds__(NWAVES * 64, 2) mk_fwd(Args args) {
    extern __shared__ __attribute__((aligned(16))) unsigned char lds_raw[];
    LAS unsigned char* lds = (LAS unsigned char*)lds_raw;
    volatile LAS unsigned* MISC = (volatile LAS unsigned*)(lds + MISC_OFF);
    const int tid = threadIdx.x, wave = __builtin_amdgcn_readfirstlane(tid >> 6);
#define lane (tid & 63)
    const int G = gridDim.x; int vcu; { const int bx = blockIdx.x; vcu = (G % 8 == 0) ? (bx % 8) * (G / 8) + bx / 8 : bx; }
    unsigned char* ws = args.ws;
    unsigned* ctl = (unsigned*)(ws + WS_CTL);
    float* ssq = (float*)(ctl + CW_SSQ);
#define SSQ_ARR(k) ((k) == 0 ? ssq : ((k) == 4 ? (float*)(ws + 1 * MiB) : (float*)args.out + (size_t)((k) - 1) * 4096))
#define SSQ_PS(k) (((k) >= 1 && (k) <= 3) ? 262144 : 4096)
#define SSQ_NP(k) ((k) == 0 ? 1 : 16)
    LAS float* rtab = (LAS float*)(lds + LDSCTL_OFF + 1024);
#define RSTD_TABLE(arr, np_, ps_) { pg8::Unit u0; const bool any = S.next(0, u0); __syncthreads(); \
        if (any && tid < 256) rtab[tid] = rsqrtf(pg8::row_ssq((arr), (np_), u0.pm * 256 + tid, (ps_)) * (1.0f / 1024.0f) + pg8::RMS_EPS); __syncthreads(); }
    float* out = args.out;
    bf16* HB = (bf16*)(ws + WS_HB); bf16* DA = (bf16*)(ws + WS_DA); bf16* MG = (bf16*)(ws + WS_MG); bf16* PROJ = (bf16*)(ws + WS_PROJ); bf16* ACT = PROJ;
    for (int u = tid; u < (LDS_BYTES - LDSCTL_OFF) / 4; u += NWAVES * 64) ((LAS unsigned*)(lds + LDSCTL_OFF))[u] = 0u;
    __syncthreads();
    XcdBarrier bar; bar.bar = ctl + CW_BAR; bar.x = 0; bar.st = nullptr;
    if (N_LAUNCHES == 1) bar = xcd_barrier_post(ctl + CW_BAR, MISC + 8);
    if (N_LAUNCHES == 1 && tid == 0) ctl[CW_XCCTAB + blockIdx.x] = bar.x + 1u;
    const int lo = args.ph_lo, hi = args.ph_hi;
#define IN(k) (lo <= (k) && (k) < hi)
#ifdef DBG_XBAR
#define SEAM(k) do { if (IN(k) && IN((k) + 1)) { xcd_barrier(bar); xcd_barrier(bar); } } while (0)
#else
#define SEAM(k) do { if (IN(k) && IN((k) + 1)) xcd_barrier(bar); } while (0)
#endif
    const int gw = vcu * NWAVES + wave, NGW = G * NWAVES;
    bool xl_fast = false;
#ifndef MK_GRID_SEAMS_ONLY
#define SEAM_G(k) do { if (IN(k) && IN((k) + 1)) { if (xl_fast) xcc_local_barrier(ctl + CW_BAR2, bar.x, bar.st[0], bar.bar); else xcd_barrier(bar); } } while (0)
#else
#define SEAM_G(k) SEAM(k)
#endif

    for (int rep = 0; rep < ((DBG_DOUBLE & 1) ? 2 : 1); ++rep)
    if (IN(0) && (DBG_MASK & 1)) {
        LAS float* scr = (LAS float*)(lds + RING_OFF + wave * TR_SCR_BYTES);
        convert_layer_items(args.in, ws, 0, gw, NGW, scr, lane, 0);
        const float* x = args.in[0];
        for (int m = gw; m < M; m += 2 * NGW) {
            const int m1 = m + NGW;
            const bool has1 = m1 < M;
            const GAS f32x4* xr0 = (const GAS f32x4*)(x + (size_t)m * DM) + lane;
            const GAS f32x4* xr1 = (const GAS f32x4*)(x + (size_t)(has1 ? m1 : m) * DM) + lane;
            f32x4 v0[4], v1[4]; float s0 = 0.f, s1 = 0.f;
#pragma unroll
            for (int j = 0; j < 4; ++j) { v0[j] = xr0[64 * j]; v1[j] = xr1[64 * j]; }
#pragma unroll
            for (int j = 0; j < 4; ++j) { s0 += (v0[j].x * v0[j].x + v0[j].y * v0[j].y) + (v0[j].z * v0[j].z + v0[j].w * v0[j].w); s1 += (v1[j].x * v1[j].x + v1[j].y * v1[j].y) + (v1[j].z * v1[j].z + v1[j].w * v1[j].w); }
            s0 = wave_sum(s0); s1 = wave_sum(s1);
            GAS unsigned long long* o0 = (GAS unsigned long long*)(HB + (size_t)m * DM) + lane;
#pragma unroll
            for (int j = 0; j < 4; ++j) o0[64 * j] = (unsigned long long)pk2(v0[j].x, v0[j].y) | ((unsigned long long)pk2(v0[j].z, v0[j].w) << 32);
            if (lane == 0) ssq[m] = s0;
            if (has1) {
                GAS unsigned long long* o1 = (GAS unsigned long long*)(HB + (size_t)m1 * DM) + lane;
#pragma unroll
                for (int j = 0; j < 4; ++j) o1[64 * j] = (unsigned long long)pk2(v1[j].x, v1[j].y) | ((unsigned long long)pk2(v1[j].z, v1[j].w) << 32);
                if (lane == 0) ssq[m1] = s1;
            }
        }
    }
    SEAM(0);
    if (N_LAUNCHES == 1 && IN(0) && IN(1) && G == 256) {
        if (wave == 0) {
            const int t = tid;
            const unsigned* tab = ctl + CW_XCCTAB + (t >> 3) + 8 * (t & 7);
            const unsigned i0 = tab[0], i1 = tab[64], i2 = tab[128], i3 = tab[192];
            const bool same = (i0 != 0u) && (i0 == i1) && (i0 == i2) && (i0 == i3);
            const bool all = __all(same);
            if (tid == 0) MISC[12] = all ? 1u : 0u;
        }
        __syncthreads();
        xl_fast = (MISC[12] != 0u);
    }

#pragma unroll 1
    for (int l = 0; l < DEPTH; ++l) {
        const int pb = 1 + 6 * l;
        unsigned char* wl = ws + WS_W + (size_t)l * W_LAYER;
        for (int rep = 0; rep < ((DBG_DOUBLE & 2) ? 2 : 1); ++rep)
        if (IN(pb + 0) && (DBG_MASK & 2)) {
            pg8::Gemm g{HB, (const bf16*)(wl + WO_IN), DM, DM, DM}; pg8::StaticOrder S; S.init(M, INW, G, (int)blockIdx.x, 1);
            RSTD_TABLE(SSQ_ARR(2 * l), SSQ_NP(2 * l), SSQ_PS(2 * l));
            pg8::EpiProj E{PROJ, rtab};
            pg8::gemm_phase<pg8::EpiProj, pg8::StaticOrder, true, true>(lds + RING_OFF, g, S, E);
            {
                const int rem = ((M / 256) * (INW / 256)) % G;
                int lane_o = lane; asm volatile("" : "+v"(lane_o));
                if ((int)blockIdx.x >= rem) convert_layer_items(args.in, ws, l, ((int)blockIdx.x - rem) * NWAVES + wave, (G - rem) * NWAVES, (LAS float*)(lds + RING_OFF + wave * TR_SCR_BYTES), lane_o, 1);
                if (DBG_DOUBLE) __syncthreads();
            }
        }
        SEAM(pb + 0);
        for (int rep = 0; rep < ((DBG_DOUBLE & 4) ? 2 : 1); ++rep)
        if (IN(pb + 1) && (DBG_MASK & 4)) {
            int tid_o = tid; asm volatile("" : "+v"(tid_o));
            if (G == 256) {
                const int bx = (int)blockIdx.x, pmc = (bx % 8) * 8 + (bx / 8) % 8, j = bx / 64;
                attn_unit(lds + RING_OFF, PROJ, DA, args.in[5] + l * 8, (pmc / 16) * 64 + (j & 1) * 32 + 2 * (pmc % 16) + (j >> 1), tid_o, wave, tid_o & 63);
                pool_tokens8(PROJ, DA, 256 * pmc + 64 * j + 8 * wave, tid_o & 63);
            } else {
                for (int u = vcu; u < BATCH * 2 * 32; u += G) attn_unit(lds + RING_OFF, PROJ, DA, args.in[5] + l * 8, u, tid_o, wave, tid_o & 63);
                for (int t8 = gw; t8 < M / 8; t8 += NGW) pool_tokens8(PROJ, DA, t8 * 8, tid_o & 63);
            }
        }
        SEAM_G(pb + 1);
        if (xl_fast && (int)blockIdx.x < 64 && tid == 0) (void)xb_add(ctl + CW_PBD + 64 * (((int)blockIdx.x % 8) * 8 + ((int)blockIdx.x / 8) % 8), 1u);
        for (int rep = 0; rep < ((DBG_DOUBLE & 8) ? 2 : 1); ++rep)
        if (IN(pb + 2) && (DBG_MASK & 8)) {
            pg8::Gemm g{DA, (const bf16*)(wl + WO_PA), DM, DM, 512}; pg8::StaticOrder S; S.init(M, DM, G, (int)blockIdx.x, 2);
            pg8::EpiMerge E{PROJ, MG};
            pg8::gemm_phase<pg8::EpiMerge, pg8::StaticOrder, true, true>(lds + RING_OFF, g, S, E);
        }
        SEAM_G(pb + 2);
        for (int rep = 0; rep < (((DBG_DOUBLE & 16) && l == 0) ? 2 : 1); ++rep)
        if (IN(pb + 3) && (DBG_MASK & 16)) {
            pg8::Gemm g{MG, (const bf16*)(wl + WO_OUT), DM, DM, DM}; pg8::StaticOrder S; S.init(M, DM, G, (int)blockIdx.x, 1);
            pg8::EpiResid E{HB, HB, SSQ_ARR(2 * l + 1), SSQ_PS(2 * l + 1)};
            pg8::gemm_phase<pg8::EpiResid, pg8::StaticOrder, true, true>(lds + RING_OFF, g, S, E);
        }
        SEAM_G(pb + 3);
        for (int rep = 0; rep < ((DBG_DOUBLE & 32) ? 2 : 1); ++rep)
        if (IN(pb + 4) && (DBG_MASK & 32)) {
            pg8::Gemm g{HB, (const bf16*)(wl + WO_GU), DM, DM, DM}; pg8::StaticOrder S; S.init(M, NGU, G, (int)blockIdx.x, 1);
            if (xl_fast && tid == 0) {
                const int pmc = ((int)blockIdx.x % 8) * 8 + ((int)blockIdx.x / 8) % 8;
                if (pmc > 0)  XB_SPIN(xb_ld(ctl + CW_PBD + 64 * (pmc - 1)) < (unsigned)(l + 1), bar.bar);
                if (pmc < 63) XB_SPIN(xb_ld(ctl + CW_PBD + 64 * (pmc + 1)) < (unsigned)(l + 1), bar.bar);
            }
            RSTD_TABLE(SSQ_ARR(2 * l + 1), 16, SSQ_PS(2 * l + 1));
            pg8::EpiSwiglu E{ACT, rtab};
            pg8::gemm_phase<pg8::EpiSwiglu, pg8::StaticOrder, true, true>(lds + RING_OFF, g, S, E);
            if (l + 1 < DEPTH) {
                const int rem = ((M / 256) * (NGU / 256)) % G;
                int lane_o = lane; asm volatile("" : "+v"(lane_o));
                if ((int)blockIdx.x >= rem) convert_layer_items(args.in, ws, l + 1, ((int)blockIdx.x - rem) * NWAVES + wave, (G - rem) * NWAVES, (LAS float*)(lds + RING_OFF + wave * TR_SCR_BYTES), lane_o, 0);
                if (DBG_DOUBLE) __syncthreads();
            }
        }
        SEAM_G(pb + 4);
        if (IN(pb + 5) && (DBG_MASK & 64)) {
            pg8::Gemm g{ACT, (const bf16*)(wl + WO_D), INW, DFF, DFF};     pg8::StaticOrder S; S.init(M, DM, G, (int)blockIdx.x, 1);
            pg8::EpiResid E{HB, HB, SSQ_ARR(2 * l + 2), SSQ_PS(2 * l + 2)};
            pg8::gemm_phase<pg8::EpiResid, pg8::StaticOrder, true, true>(lds + RING_OFF, g, S, E);
        }
        if (l == DEPTH - 1) SEAM_G(pb + 5); else SEAM(pb + 5);
    }
    if (IN(N_PHASES - 1) && (DBG_MASK & 128)) {
        const float* gain = args.in[13]; const float* sq = SSQ_ARR(2 * DEPTH);
        f32x4 gv[4];
#pragma unroll
        for (int j = 0; j < 4; ++j) gv[j] = ((const GAS f32x4*)gain)[2 * lane + (j & 1) + 128 * (j >> 1)];
        const bool own = (G == 256);
        const int fbase = own ? 256 * (((int)blockIdx.x % 8) * 8 + ((int)blockIdx.x / 8) % 8) + 64 * ((int)blockIdx.x / 64) + 8 * wave : gw;
        const int fstep = own ? 2 : 2 * NGW, fend = own ? fbase + 8 : M, fsec = own ? 1 : NGW;
        for (int m = fbase; m < fend; m += fstep) {
            const int m1 = (m + fsec < fend) ? m + fsec : m;
            const v4u a0 = *(const GAS v4u*)(HB + (size_t)m * DM + 8 * lane), a1 = *(const GAS v4u*)(HB + (size_t)m * DM + 512 + 8 * lane);
            const v4u b0 = *(const GAS v4u*)(HB + (size_t)m1 * DM + 8 * lane), b1 = *(const GAS v4u*)(HB + (size_t)m1 * DM + 512 + 8 * lane);
            const float rs0 = rsqrtf(pg8::row_ssq(sq, 16, m, SSQ_PS(2 * DEPTH)) * (1.0f / 1024.0f) + pg8::RMS_EPS), rs1 = rsqrtf(pg8::row_ssq(sq, 16, m1, SSQ_PS(2 * DEPTH)) * (1.0f / 1024.0f) + pg8::RMS_EPS);
            GAS f32x4* o0 = (GAS f32x4*)(out + (size_t)m * DM + 8 * lane); GAS f32x4* o1 = (GAS f32x4*)(out + (size_t)m1 * DM + 8 * lane);
            o0[0] = (f32x4){bflo(a0.x), bfhi(a0.x), bflo(a0.y), bfhi(a0.y)} * rs0 * gv[0]; o0[1] = (f32x4){bflo(a0.z), bfhi(a0.z), bflo(a0.w), bfhi(a0.w)} * rs0 * gv[1];
            o0[128] = (f32x4){bflo(a1.x), bfhi(a1.x), bflo(a1.y), bfhi(a1.y)} * rs0 * gv[2]; o0[129] = (f32x4){bflo(a1.z), bfhi(a1.z), bflo(a1.w), bfhi(a1.w)} * rs0 * gv[3];
            if (m1 != m) {
                o1[0] = (f32x4){bflo(b0.x), bfhi(b0.x), bflo(b0.y), bfhi(b0.y)} * rs1 * gv[0]; o1[1] = (f32x4){bflo(b0.z), bfhi(b0.z), bflo(b0.w), bfhi(b0.w)} * rs1 * gv[1];
                o1[128] = (f32x4){bflo(b1.x), bfhi(b1.x), bflo(b1.y), bfhi(b1.y)} * rs1 * gv[2]; o1[129] = (f32x4){bflo(b1.z), bfhi(b1.z), bflo(b1.w), bfhi(b1.w)} * rs1 * gv[3];
            }
        }
    }
#undef lane
#undef IN
#undef SEAM
#undef SEAM_G
}

extern "C" void kernel_launch(void* const* d_in, const int* in_sizes, int n_in, void* d_out, int out_size, void* d_ws, size_t ws_size, hipStream_t stream) {
    static int grid = 0;
    if (grid == 0) {
        if (n_in != 14 || in_sizes[0] != M * DM || out_size != M * DM || ws_size < WS_END) { fprintf(stderr, "kernel_launch: unexpected shapes (n_in %d, in0 %d, out %d, ws %zu); nothing launched\n", n_in, n_in > 0 ? in_sizes[0] : -1, out_size, ws_size); grid = -1; return; }
        int dev = 0, cus = 0, per_cu = 0;
        if (hipGetDevice(&dev) != hipSuccess || hipDeviceGetAttribute(&cus, hipDeviceAttributeMultiprocessorCount, dev) != hipSuccess) { grid = -1; return; }
        if (hipFuncSetAttribute((const void*)mk_fwd, hipFuncAttributeMaxDynamicSharedMemorySize, LDS_BYTES) != hipSuccess) { fprintf(stderr, "kernel_launch: hipFuncSetAttribute failed\n"); grid = -1; return; }
        if (hipOccupancyMaxActiveBlocksPerMultiprocessor(&per_cu, (const void*)mk_fwd, NWAVES * 64, LDS_BYTES) != hipSuccess || per_cu < 1) fprintf(stderr, "kernel_launch: occupancy query reports %d workgroups per CU\n", per_cu);
        (void)hipGetLastError();
        grid = cus >= 64 ? (cus / 64) * 64 : cus;
        if (grid % 64 != 0) { fprintf(stderr, "kernel_launch: needs a grid that is a multiple of 64 workgroups (got %d CUs); nothing launched\n", cus); grid = -1; return; }
    }
    if (grid < 0) return;
    if (hipMemsetAsync((char*)d_ws + WS_CTL, 0, CTL_ZERO_BYTES, stream) != hipSuccess) { fprintf(stderr, "kernel_launch: hipMemsetAsync failed\n"); return; }
    Args a{};
    for (int i = 0; i < 14; ++i) a.in[i] = (const float*)d_in[i];
    a.out = (float*)d_out; a.ws = (unsigned char*)d_ws;
    if (N_LAUNCHES == 1) {
        a.ph_lo = 0; a.ph_hi = N_PHASES; a.li = 0;
        hipLaunchKernelGGL(mk_fwd, dim3(grid), dim3(NWAVES * 64), LDS_BYTES, stream, a);
    } else {
        for (int li = 0; li < N_PHASES; ++li) { a.ph_lo = li; a.ph_hi = li + 1; a.li = li; hipLaunchKernelGGL(mk_fwd, dim3(grid), dim3(NWAVES * 64), LDS_BYTES, stream, a); }
    }
}
```

```cpp
#include <hip/hip_runtime.h>
#include <cstdio>
#include <cstdint>

#ifndef MK_N_LAUNCHES
#define MK_N_LAUNCHES 1
#endif

namespace pg8 {
#define PG8_LAS __attribute__((address_space(3)))
typedef unsigned short bf16_t;
typedef short bf16x8 __attribute__((ext_vector_type(8)));
typedef float f32x4 __attribute__((ext_vector_type(4)));
typedef unsigned u32x4 __attribute__((ext_vector_type(4)));
constexpr int BM = 256, BK = 64, HALF = 128, HTB = HALF * BK * 2  , STAGE_BYTES = 8 * HTB, NXCD = 8, WGM = 8;

__host__ __device__ __forceinline__ int lds_byte(int r, int c) { const int st = (r >> 4) * 2 + (c >> 5), rr = r & 15, cc = c & 31, ob = rr * 64 + cc * 2; return st * 1024 + (ob ^ (((ob >> 9) & 1) << 5)); }
__host__ __device__ __forceinline__ void stage_rc(int b, int& R, int& C) { const int st = b / 1024, sb = b % 1024, swz = sb ^ (((sb >> 9) & 1) << 5); R = (st >> 1) * 16 + swz / 64; C = (st & 1) * 32 + (swz % 64) / 2; }
__host__ __device__ __forceinline__ int perm32(int rho) { const int n = rho >> 4, i = rho & 15; return 8 * (i >> 2) + 4 * n + (i & 3); }

struct Unit { int pm, pn, seg; };
struct Gemm { const bf16_t* A; const bf16_t* Bt; int ld, ldb, K; };

struct StaticOrder {
    int nM, nN, nwg, G, c, nseg, paperm;
    __device__ void init(int M, int N, int G_, int c_, int nseg_, int paperm_ = 0) { nM = M / BM; nN = N / BM; nwg = nM * nN; G = G_; c = c_; nseg = nseg_; paperm = paperm_; }
    __device__ bool next(int i, Unit& u) const {
        const int ui = i / nseg; u.seg = i - ui * nseg;
        const int L = ui * G + c; if (L >= nwg) return false;
        int wgid = L; { const int q = nwg / NXCD, r = nwg % NXCD, xcd = wgid % NXCD, off = wgid / NXCD; wgid = (xcd < r ? xcd * (q + 1) : r * (q + 1) + (xcd - r) * q) + off; }
        const int nig = WGM * nN, gid = wgid / nig, fm = gid * WGM, gsz = (nM - fm) < WGM ? (nM - fm) : WGM;
        u.pm = fm + ((wgid % nig) % gsz); u.pn = (wgid % nig) / gsz;
        if (paperm) u.pn = (int)((0x3CBA298716540ULL >> (4 * u.pn)) & 15ULL);
        return true;
    }
};

typedef float f32x2c __attribute__((ext_vector_type(2))); typedef __bf16 bf16x2c __attribute__((ext_vector_type(2)));
__device__ __forceinline__ unsigned cvt_pk_bf16(float lo, float hi) { f32x2c v = {lo, hi}; bf16x2c b = __builtin_convertvector(v, bf16x2c); return __builtin_bit_cast(unsigned, b); }
__device__ __forceinline__ float bf_lo(unsigned w) { return __uint_as_float(w << 16); }
__device__ __forceinline__ float bf_hi(unsigned w) { return __uint_as_float(w & 0xffff0000u); }
__device__ __forceinline__ float sigmoidf_fast(float v) { return __builtin_amdgcn_rcpf(1.0f + __builtin_amdgcn_exp2f(-1.4426950408889634f * v)); }

constexpr float RMS_EPS = 1e-6f;
__device__ __forceinline__ float row_ssq(const float* ssq, int np, int row, int pstride) {
    if (np == 1) return ssq[row];
    const f32x4* q = (const f32x4*)(ssq + (size_t)(row >> 8) * pstride + (row & 255) * 16);
    const f32x4 a = q[0], b = q[1], c = q[2], d = q[3];
    return (((a[0] + a[1]) + (a[2] + a[3])) + ((b[0] + b[1]) + (b[2] + b[3]))) + (((c[0] + c[1]) + (c[2] + c[3])) + ((d[0] + d[1]) + (d[2] + d[3])));
}
constexpr float QSCALE = 0.125f * 1.4426950408889634f;


struct EpiProj {
    static constexpr bool PERM = true, AFTER_DRAIN = false;
    bf16_t* O; const PG8_LAS float* rtab;
    __device__ __forceinline__ void operator()(f32x4 (&acc)[2][2][4][2], const Unit& u, int wr, int wc, int fr, int fq) const {
        const int row0 = u.pm * BM + wr * 64 + fr, cin = wc * 32 + 8 * fq;
        const bool isq = (u.pn == 2 || u.pn == 3), isg = (u.pn >= 5);
#pragma unroll
        for (int ai = 0; ai < 2; ++ai)
#pragma unroll
            for (int m = 0; m < 4; ++m) {
                const int row = row0 + ai * HALF + m * 16;
                float rs = rtab[wr * 64 + fr + ai * HALF + m * 16]; if (isq) rs *= QSCALE;
                bf16_t* rowp = O + (size_t)row * 3328;
                if (!isg) {
#pragma unroll
                    for (int bj = 0; bj < 2; ++bj) {
                        const f32x4 v0 = acc[ai][bj][m][0] * rs, v1 = acc[ai][bj][m][1] * rs;
                        u32x4 w; w.x = cvt_pk_bf16(v0[0], v0[1]); w.y = cvt_pk_bf16(v0[2], v0[3]); w.z = cvt_pk_bf16(v1[0], v1[1]); w.w = cvt_pk_bf16(v1[2], v1[3]);
                        *(u32x4*)(rowp + u.pn * BM + bj * HALF + cin) = w;
                    }
                } else {
                    const float nl = -1.4426950408889634f * rs;
                    f32x4 r0, r1, s0, s1;
#pragma unroll
                    for (int e = 0; e < 4; ++e) {
                        const float ep0 = __builtin_amdgcn_exp2f(acc[ai][0][m][0][e] * nl), ea0 = __builtin_amdgcn_exp2f(acc[ai][1][m][0][e] * nl);
                        const float ep1 = __builtin_amdgcn_exp2f(acc[ai][0][m][1][e] * nl), ea1 = __builtin_amdgcn_exp2f(acc[ai][1][m][1][e] * nl);
                        s0[e] = __builtin_amdgcn_rcpf(1.0f + ea0); s1[e] = __builtin_amdgcn_rcpf(1.0f + ea1);
                        r0[e] = (1.0f + ea0) * __builtin_amdgcn_rcpf(1.0f + ep0); r1[e] = (1.0f + ea1) * __builtin_amdgcn_rcpf(1.0f + ep1);
                    }
                    const int j = (u.pn - 5) * HALF + cin;
                    u32x4 w; w.x = cvt_pk_bf16(r0[0], r0[1]); w.y = cvt_pk_bf16(r0[2], r0[3]); w.z = cvt_pk_bf16(r1[0], r1[1]); w.w = cvt_pk_bf16(r1[2], r1[3]);
                    *(u32x4*)(rowp + 1280 + j) = w;
                    w.x = cvt_pk_bf16(s0[0], s0[1]); w.y = cvt_pk_bf16(s0[2], s0[3]); w.z = cvt_pk_bf16(s1[0], s1[1]); w.w = cvt_pk_bf16(s1[2], s1[3]);
                    *(u32x4*)(rowp + 2304 + j) = w;
                }
                __builtin_amdgcn_sched_barrier(0);
            }
    }
};

struct EpiMerge {
    static constexpr bool PERM = true, AFTER_DRAIN = false;
    const bf16_t* P; bf16_t* O;
    __device__ __forceinline__ void operator()(f32x4 (&acc)[2][2][4][2], const Unit& u, int wr, int wc, int fr, int fq) const {
        const int row0 = u.pm * BM + wr * 64 + fr, col0 = u.pn * BM + wc * 32 + 8 * fq;
        const int gcol = (u.seg == 0 ? 1280 : 2304) + col0;
#pragma unroll
        for (int ai = 0; ai < 2; ++ai) {
            u32x4 ga[4][2];
#pragma unroll
            for (int m = 0; m < 4; ++m)
#pragma unroll
                for (int bj = 0; bj < 2; ++bj) ga[m][bj] = *(const u32x4*)(P + (size_t)(row0 + ai * HALF + m * 16) * 3328 + gcol + bj * HALF);
#pragma unroll
            for (int m = 0; m < 4; ++m)
#pragma unroll
                for (int bj = 0; bj < 2; ++bj) {
                    const u32x4 g = ga[m][bj];
                    const f32x4 a0 = (f32x4){bf_lo(g.x), bf_hi(g.x), bf_lo(g.y), bf_hi(g.y)}, a1 = (f32x4){bf_lo(g.z), bf_hi(g.z), bf_lo(g.w), bf_hi(g.w)};
                    acc[ai][bj][m][0] *= a0; acc[ai][bj][m][1] *= a1;
                    if (u.seg != 0) {
                        const f32x4 v0 = acc[ai][bj][m][0], v1 = acc[ai][bj][m][1];
                        u32x4 w; w.x = cvt_pk_bf16(v0[0], v0[1]); w.y = cvt_pk_bf16(v0[2], v0[3]); w.z = cvt_pk_bf16(v1[0], v1[1]); w.w = cvt_pk_bf16(v1[2], v1[3]);
                        *(u32x4*)(O + (size_t)(row0 + ai * HALF + m * 16) * 1024 + col0 + bj * HALF) = w;
                    }
                }
        }
    }
};

struct EpiResid {
    static constexpr bool PERM = true, AFTER_DRAIN = false;
    const bf16_t* baseh; bf16_t* outh; float* ssq; int pstride;
    __device__ __forceinline__ void operator()(f32x4 (&acc)[2][2][4][2], const Unit& u, int wr, int wc, int fr, int fq) const {
        const int row0 = u.pm * BM + wr * 64 + fr, col0 = u.pn * BM + wc * 32 + 8 * fq;
#pragma unroll
        for (int ai = 0; ai < 2; ++ai) {
            u32x4 bb[4][2];
#pragma unroll
            for (int m = 0; m < 4; ++m)
#pragma unroll
                for (int bj = 0; bj < 2; ++bj) bb[m][bj] = *(const u32x4*)(baseh + (size_t)(row0 + ai * HALF + m * 16) * 1024 + col0 + bj * HALF);
#pragma unroll
            for (int m = 0; m < 4; ++m) {
                const int row = row0 + ai * HALF + m * 16; float s = 0.f;
#pragma unroll
                for (int bj = 0; bj < 2; ++bj) {
                    const u32x4 b = bb[m][bj];
                    const f32x4 v0 = acc[ai][bj][m][0] + (f32x4){bf_lo(b.x), bf_hi(b.x), bf_lo(b.y), bf_hi(b.y)}, v1 = acc[ai][bj][m][1] + (f32x4){bf_lo(b.z), bf_hi(b.z), bf_lo(b.w), bf_hi(b.w)};
                    s += (v0[0] * v0[0] + v0[1] * v0[1]) + (v0[2] * v0[2] + v0[3] * v0[3]) + (v1[0] * v1[0] + v1[1] * v1[1]) + (v1[2] * v1[2] + v1[3] * v1[3]);
                    u32x4 w; w.x = cvt_pk_bf16(v0[0], v0[1]); w.y = cvt_pk_bf16(v0[2], v0[3]); w.z = cvt_pk_bf16(v1[0], v1[1]); w.w = cvt_pk_bf16(v1[2], v1[3]);
                    *(u32x4*)(outh + (size_t)row * 1024 + col0 + bj * HALF) = w;
                }
                s += __shfl_xor(s, 16); s += __shfl_xor(s, 32);
                if (fq == 0) ssq[(size_t)(row >> 8) * pstride + (row & 255) * 16 + u.pn * 4 + wc] = s;
            }
        }
    }
};

struct EpiSwiglu {
    static constexpr bool PERM = true, AFTER_DRAIN = false;
    bf16_t* O; const PG8_LAS float* rtab;
    __device__ __forceinline__ void operator()(f32x4 (&acc)[2][2][4][2], const Unit& u, int wr, int wc, int fr, int fq) const {
        const int row0 = u.pm * BM + wr * 64 + fr, col0 = u.pn * HALF + wc * 32 + 8 * fq;
#pragma unroll
        for (int ai = 0; ai < 2; ++ai)
#pragma unroll
            for (int m = 0; m < 4; ++m) {
                const int row = row0 + ai * HALF + m * 16;
                const float rs = rtab[wr * 64 + fr + ai * HALF + m * 16];
                f32x4 o[2];
#pragma unroll
                for (int n = 0; n < 2; ++n) {
                    const f32x4 g = acc[ai][0][m][n] * rs, up = acc[ai][1][m][n] * rs;
#pragma unroll
                    for (int e = 0; e < 4; ++e) o[n][e] = g[e] * sigmoidf_fast(g[e]) * up[e];
                }
                u32x4 w; w.x = cvt_pk_bf16(o[0][0], o[0][1]); w.y = cvt_pk_bf16(o[0][2], o[0][3]); w.z = cvt_pk_bf16(o[1][0], o[1][1]); w.w = cvt_pk_bf16(o[1][2], o[1][3]);
                *(u32x4*)(O + (size_t)row * 3328 + col0) = w;
            }
    }
};

template <class Epi, class Sched, bool ALIGN_EPI = false, bool SP2 = false>
__device__ __forceinline__ void gemm_phase(PG8_LAS unsigned char* lds, const Gemm g, const Sched& S, const Epi& E) {
    int tid_o = threadIdx.x; asm volatile("" : "+v"(tid_o));
    const int tid = tid_o, wid = __builtin_amdgcn_readfirstlane(tid >> 6), lane = tid & 63, wr = wid >> 2, wc = wid & 3, fr = lane & 15, fq = lane >> 4;
    const int K = g.K, nt = K / BK, ld = g.ld, ldb = g.ldb;
    unsigned voffA[2], voffB[2];
#pragma unroll
    for (int i = 0; i < 2; ++i) { int R, C; stage_rc(tid * 16 + i * 8192, R, C); const int Rb = Epi::PERM ? ((R & ~31) + perm32(R & 31)) : R;
        voffA[i] = (unsigned)(R * ld + C) * 2u; voffB[i] = (unsigned)(Rb * ldb + C) * 2u; }
    const unsigned kstep = (unsigned)(BK * 2);
    const unsigned hstep = (unsigned)HALF * (unsigned)ld * 2u;
    const unsigned tstep = 2u * hstep;
    const unsigned hstepB = (unsigned)HALF * (unsigned)ldb * 2u, tstepB = 2u * hstepB;
    const unsigned ldsw = (unsigned)wid * 1024u;
    const int aoff = lds_byte(wr * 64 + fr, fq * 8), boff = lds_byte(wc * 32 + fr, fq * 8);
#define PG8_SA(b, h) (((b) * 2 + (h)) * HTB)
#define PG8_SB(b, h) ((4 + (b) * 2 + (h)) * HTB)
#define PG8_STAGE(bufoff, gbase, voff) do { _Pragma("unroll") for (int _i = 0; _i < 2; ++_i) \
        __builtin_amdgcn_global_load_lds((const unsigned*)((const char*)(gbase) + (voff)[_i]), (PG8_LAS unsigned*)(lds + (bufoff) + ldsw + _i * 8192), 16, 0, 0); } while (0)
#define PG8_LDA(dst, b, h) do { _Pragma("unroll") for (int m = 0; m < 4; ++m) _Pragma("unroll") for (int k = 0; k < 2; ++k) dst[m][k] = *(const PG8_LAS bf16x8*)(lds + PG8_SA(b, h) + aoff + m * 2048 + k * 1024); } while (0)
#define PG8_LDB(dst, b, h) do { _Pragma("unroll") for (int n = 0; n < 2; ++n) _Pragma("unroll") for (int k = 0; k < 2; ++k) dst[n][k] = *(const PG8_LAS bf16x8*)(lds + PG8_SB(b, h) + boff + n * 2048 + k * 1024); } while (0)
#define PG8_MMA(ai, bj, At, Bt) do { __builtin_amdgcn_s_setprio(1); _Pragma("unroll") for (int m = 0; m < 4; ++m) _Pragma("unroll") for (int n = 0; n < 2; ++n) _Pragma("unroll") for (int k = 0; k < 2; ++k) \
        acc[ai][bj][m][n] = __builtin_amdgcn_mfma_f32_16x16x32_bf16(Bt[n][k], At[m][k], acc[ai][bj][m][n], 0, 0, 0); __builtin_amdgcn_s_setprio(0); } while (0)
#define PG8_WAIT_V(n) asm volatile("s_waitcnt vmcnt(" #n ")" ::: "memory")
#define PG8_WAIT_L(n) asm volatile("s_waitcnt lgkmcnt(" #n ")" ::: "memory")
#define PG8_BAR __builtin_amdgcn_s_barrier()
#define PG8_SCHED __builtin_amdgcn_sched_barrier(0)
    Unit cur, nxt; int ui = 0;
    if (!S.next(0, cur)) return;
    f32x4 acc[2][2][4][2];
#pragma unroll
    for (int a = 0; a < 2; ++a)
#pragma unroll
        for (int b = 0; b < 2; ++b)
#pragma unroll
            for (int m = 0; m < 4; ++m)
#pragma unroll
                for (int n = 0; n < 2; ++n) acc[a][b][m][n] = (f32x4){0.f, 0.f, 0.f, 0.f};
    bf16x8 At[4][2], B0[2][2], B1[2][2];
    const char* cA = (const char*)g.A + (size_t)cur.pm * tstep + (size_t)cur.seg * K * 2; const char* cB = (const char*)g.Bt + (size_t)cur.pn * tstepB + (size_t)cur.seg * K * 2;
    if constexpr (SP2) {
        PG8_STAGE(PG8_SB(0, 0), cB, voffB); PG8_STAGE(PG8_SB(0, 1), cB + hstepB, voffB); PG8_STAGE(PG8_SA(0, 0), cA, voffA); PG8_STAGE(PG8_SA(0, 1), cA + hstep, voffA);
        if (wr == 1) PG8_BAR;
        PG8_WAIT_V(2); PG8_BAR;
        PG8_STAGE(PG8_SB(1, 0), cB + kstep, voffB); PG8_STAGE(PG8_SA(1, 0), cA + kstep, voffA); PG8_STAGE(PG8_SB(1, 1), cB + hstepB + kstep, voffB);
        PG8_WAIT_V(6); PG8_BAR;
    } else {
        PG8_STAGE(PG8_SB(0, 0), cB, voffB); PG8_STAGE(PG8_SA(0, 0), cA, voffA); PG8_STAGE(PG8_SB(0, 1), cB + hstepB, voffB); PG8_STAGE(PG8_SA(0, 1), cA + hstep, voffA);
        if (wr == 1) PG8_BAR;
        PG8_WAIT_V(4); PG8_BAR;
        PG8_STAGE(PG8_SB(1, 0), cB + kstep, voffB); PG8_STAGE(PG8_SA(1, 0), cA + kstep, voffA); PG8_STAGE(PG8_SB(1, 1), cB + hstepB + kstep, voffB);
        PG8_WAIT_V(6); PG8_BAR;
    }
    for (;;) {
        const bool has_next = S.next(ui + 1, nxt);
        const char* nA = has_next ? (const char*)g.A + (size_t)nxt.pm * tstep + (size_t)nxt.seg * K * 2 : cA; const char* nB = has_next ? (const char*)g.Bt + (size_t)nxt.pn * tstepB + (size_t)nxt.seg * K * 2 : cB;
        for (int t = 0; t < nt; t += 2) {
            const bool last = (t == nt - 2);
            const char* a1 = cA + (size_t)(t + 1) * kstep;
            const char* a2 = last ? nA : cA + (size_t)(t + 2) * kstep; const char* b2 = last ? nB : cB + (size_t)(t + 2) * kstep;
            const char* a3 = a2 + kstep; const char* b3 = b2 + kstep;
            if constexpr (SP2) {
            PG8_LDB(B0, 0, 0); PG8_LDB(B1, 0, 1); PG8_SCHED; PG8_LDA(At, 0, 0); PG8_STAGE(PG8_SA(1, 1), a1 + hstep, voffA);
            PG8_WAIT_V(8); PG8_WAIT_L(0); PG8_BAR; PG8_MMA(0, 0, At, B0); PG8_MMA(0, 1, At, B1); PG8_BAR; PG8_SCHED;
            PG8_LDA(At, 0, 1); PG8_STAGE(PG8_SB(0, 0), b2, voffB); PG8_STAGE(PG8_SB(0, 1), b2 + hstepB, voffB); PG8_STAGE(PG8_SA(0, 0), a2, voffA);
            PG8_WAIT_V(8); PG8_WAIT_L(0); PG8_BAR; PG8_MMA(1, 0, At, B0); PG8_MMA(1, 1, At, B1); PG8_BAR; PG8_SCHED;
            PG8_LDB(B0, 1, 0); PG8_LDB(B1, 1, 1); PG8_SCHED; PG8_LDA(At, 1, 0); PG8_STAGE(PG8_SA(0, 1), a2 + hstep, voffA);
            PG8_WAIT_V(8); PG8_WAIT_L(0); PG8_BAR; PG8_MMA(0, 0, At, B0); PG8_MMA(0, 1, At, B1); PG8_BAR; PG8_SCHED;
            PG8_LDA(At, 1, 1); PG8_STAGE(PG8_SB(1, 0), b3, voffB); PG8_STAGE(PG8_SB(1, 1), b3 + hstepB, voffB); PG8_STAGE(PG8_SA(1, 0), a3, voffA);
            PG8_WAIT_V(8); PG8_WAIT_L(0); PG8_BAR; PG8_MMA(1, 0, At, B0); PG8_MMA(1, 1, At, B1); PG8_BAR; PG8_SCHED;
            } else {
            PG8_LDB(B0, 0, 0); PG8_SCHED; PG8_LDA(At, 0, 0); PG8_STAGE(PG8_SA(1, 1), a1 + hstep, voffA);
            PG8_WAIT_L(8); PG8_BAR; PG8_WAIT_L(0); PG8_MMA(0, 0, At, B0); PG8_BAR; PG8_SCHED;
            PG8_LDB(B1, 0, 1); PG8_STAGE(PG8_SB(0, 0), b2, voffB);
            PG8_BAR; PG8_WAIT_L(0); PG8_MMA(0, 1, At, B1); PG8_BAR;
            PG8_LDA(At, 0, 1); PG8_STAGE(PG8_SA(0, 0), a2, voffA);
            PG8_BAR; PG8_WAIT_L(0); PG8_MMA(1, 0, At, B0); PG8_BAR; PG8_SCHED;
            PG8_STAGE(PG8_SB(0, 1), b2 + hstepB, voffB);
            PG8_WAIT_V(6); PG8_BAR; PG8_MMA(1, 1, At, B1); PG8_BAR;
            PG8_LDB(B0, 1, 0); PG8_SCHED; PG8_LDA(At, 1, 0); PG8_STAGE(PG8_SA(0, 1), a2 + hstep, voffA);
            PG8_WAIT_L(8); PG8_BAR; PG8_WAIT_L(0); PG8_MMA(0, 0, At, B0); PG8_BAR; PG8_SCHED;
            PG8_LDB(B1, 1, 1); PG8_STAGE(PG8_SB(1, 0), b3, voffB);
            PG8_BAR; PG8_WAIT_L(0); PG8_MMA(0, 1, At, B1); PG8_BAR;
            PG8_LDA(At, 1, 1); PG8_STAGE(PG8_SA(1, 0), a3, voffA);
            PG8_BAR; PG8_WAIT_L(0); PG8_MMA(1, 0, At, B0); PG8_BAR; PG8_SCHED;
            PG8_STAGE(PG8_SB(1, 1), b3 + hstepB, voffB);
            PG8_WAIT_V(6); PG8_BAR; PG8_MMA(1, 1, At, B1); PG8_BAR;
            }
        }
        if constexpr (ALIGN_EPI) { if (wr == 0) PG8_BAR; }
        E(acc, cur, wr, wc, fr, fq);
        if (!has_next) break;
        if (nxt.seg == 0) {
#pragma unroll
        for (int a = 0; a < 2; ++a)
#pragma unroll
            for (int b = 0; b < 2; ++b)
#pragma unroll
                for (int m = 0; m < 4; ++m)
#pragma unroll
                    for (int n = 0; n < 2; ++n) acc[a][b][m][n] = (f32x4){0.f, 0.f, 0.f, 0.f};
        }
        cur = nxt; cA = nA; cB = nB; ++ui;
        if constexpr (ALIGN_EPI) { if (wr == 1) PG8_BAR; }
    }
    PG8_WAIT_V(0);
    if constexpr (!ALIGN_EPI) { if (wr == 0) PG8_BAR; }
    PG8_BAR;
#undef PG8_SA
#undef PG8_SB
#undef PG8_STAGE
#undef PG8_LDA
#undef PG8_LDB
#undef PG8_MMA
#undef PG8_WAIT_V
#undef PG8_WAIT_L
#undef PG8_BAR
#undef PG8_SCHED
}
}

constexpr int NWAVES = 8;
constexpr int DM = 1024, BATCH = 4, SEQ = 4096, DEPTH = 2, M = BATCH * SEQ;
constexpr int INW = 3328, DFF = 2816, NGU = 2 * DFF, POOLW = 512;
constexpr float LOG2E = 1.4426950408889634f;
constexpr int N_LAUNCHES = MK_N_LAUNCHES;
constexpr int N_PHASES = 2 + 6 * DEPTH;

constexpr size_t MiB = 1u << 20;
constexpr size_t WS_CTL = 0, CTL_ZERO_BYTES = 1 * MiB;
constexpr size_t WS_W = 2 * MiB, W_LAYER = 27 * MiB;
constexpr size_t WO_IN = 0, WO_PA = 13 * MiB / 2, WO_OUT = WO_PA + 2 * MiB, WO_GU = WO_OUT + 2 * MiB, WO_D = WO_GU + 11 * MiB;
static_assert(WO_D + (size_t)DM * DFF * 2 <= W_LAYER, "weight map");
constexpr size_t WS_HB = 56 * MiB;
constexpr size_t WS_MG = 88 * MiB;
constexpr size_t WS_PROJ = 120 * MiB;
constexpr size_t WS_DA = 224 * MiB;
constexpr size_t WS_END = 256 * MiB;
static_assert(WS_W + DEPTH * W_LAYER <= WS_HB && WS_PROJ + (size_t)M * INW * 2 <= WS_DA && WS_DA + (size_t)M * DM * 2 <= WS_END, "d_ws map");
constexpr int CW_BAR = 4096;
constexpr int CW_BAR2 = 8192;
constexpr int CW_PBD = 20480;
constexpr int CW_XCCTAB = 16384;
constexpr int CW_SSQ = 131072;
static_assert((CW_SSQ + M) * 4 <= (int)CTL_ZERO_BYTES && WS_CTL + CTL_ZERO_BYTES + (size_t)M * 16 * 4 <= 2 * MiB, "ctl map");

constexpr int RING_OFF = 0, RING_BYTES = 135168;
constexpr int LDSCTL_OFF = RING_BYTES, MISC_OFF = LDSCTL_OFF + 320;
constexpr int LDS_BYTES = 147456;
static_assert(MISC_OFF + 128 <= LDSCTL_OFF + 1024 && LDSCTL_OFF + 1024 + 1024 <= LDS_BYTES, "LDS map: control words, then the 1 KiB rstd table");

#define GAS __attribute__((address_space(1)))
#define LAS __attribute__((address_space(3)))
typedef unsigned short bf16;
typedef unsigned v4u __attribute__((ext_vector_type(4)));
typedef unsigned v2u __attribute__((ext_vector_type(2)));
typedef float f32x4 __attribute__((ext_vector_type(4)));
typedef float f32x16 __attribute__((ext_vector_type(16)));
typedef short bf16x8 __attribute__((ext_vector_type(8)));
typedef short s16x4 __attribute__((ext_vector_type(4)));
#define LDS_WAIT() asm volatile("s_waitcnt lgkmcnt(0)" ::: "memory")
#define VM_WAIT() asm volatile("s_waitcnt vmcnt(0)" ::: "memory")
__device__ __forceinline__ unsigned f2bf(float f) { unsigned u = __builtin_bit_cast(unsigned, f); return (u + 0x7fffu + ((u >> 16) & 1u)) >> 16; }
typedef float f32x2p __attribute__((ext_vector_type(2))); typedef __bf16 bf16x2p __attribute__((ext_vector_type(2)));
__device__ __forceinline__ unsigned pk2(float lo, float hi) { f32x2p v = {lo, hi}; bf16x2p b = __builtin_convertvector(v, bf16x2p); return __builtin_bit_cast(unsigned, b); }
__device__ __forceinline__ float bflo(unsigned w) { return __uint_as_float(w << 16); }
__device__ __forceinline__ float bfhi(unsigned w) { return __uint_as_float(w & 0xffff0000u); }

#define XB_TMO      128
#define XB_XCNT(j)  (256  + 64 * (j))
#define XB_XSUB(j)  (1280 + 64 * (j))
#define XB_XGEN(j)  (2304 + 64 * (j))
#define XB_TOP      3328
#define XB_TOPGEN   3392
#define XCD_BAR_WORDS 3456
#define XB_SPIN_CAP (1u << 18)

__device__ __forceinline__ unsigned xb_ld(unsigned* p)              { return __hip_atomic_load(p, __ATOMIC_RELAXED, __HIP_MEMORY_SCOPE_AGENT); }
__device__ __forceinline__ unsigned xb_add(unsigned* p, unsigned v) { return __hip_atomic_fetch_add(p, v, __ATOMIC_RELAXED, __HIP_MEMORY_SCOPE_AGENT); }
__device__ __forceinline__ unsigned xb_xcc_id() { return (unsigned)__builtin_amdgcn_s_getreg((3 << 11) | 20) & 0xFu; }
#define XB_SPIN(cond, bar) do { unsigned _sp = 0; while (cond) { __builtin_amdgcn_s_sleep(1); \
    if ((++_sp & 255u) == 0u) { if (xb_ld(&(bar)[XB_TMO])) break; if (_sp > XB_SPIN_CAP) { atomicAdd(&(bar)[XB_TMO], 1u); break; } } } } while (0)

struct XcdBarrier {
    unsigned* bar; unsigned x;
    volatile LAS unsigned* st;
};

__device__ __forceinline__ XcdBarrier xcd_barrier_post(unsigned* bar, volatile LAS unsigned* st) {
    XcdBarrier b; b.bar = bar; b.x = xb_xcc_id(); b.st = st;
    if (threadIdx.x == 0) (void)xb_add(&bar[XB_XCNT(b.x)], 1u);
    return b;
}
__device__ __forceinline__ void xcd_barrier_complete(unsigned* bar, unsigned x, unsigned& nloc, unsigned& nx) {
    const unsigned G = gridDim.x * gridDim.y * gridDim.z;
    unsigned sum, cnt, mine, sp = 0u;
    for (;;) {
        sum = 0u; cnt = 0u; mine = 0u;
#pragma unroll
        for (unsigned j = 0; j < 16; ++j) { const unsigned c = xb_ld(&bar[XB_XCNT(j)]); sum += c; cnt += (c > 0u) ? 1u : 0u; mine = (j == x) ? c : mine; }
        if (sum == G) break;
        __builtin_amdgcn_s_sleep(1);
        if ((++sp & 255u) == 0u) { if (xb_ld(&bar[XB_TMO])) break; if (sp > XB_SPIN_CAP) { atomicAdd(&bar[XB_TMO], 1u); break; } }
    }
    nloc = mine > 0u ? mine : 1u; nx = cnt > 0u ? cnt : 1u;
}

__device__ __forceinline__ void xcd_barrier(const XcdBarrier& b) {
    asm volatile("s_waitcnt vmcnt(0)" ::: "memory");
    __syncthreads();
    if (threadIdx.x == 0) {
        unsigned* bar = b.bar;
        __builtin_amdgcn_s_waitcnt(0);
        unsigned nloc = b.st[0], nx = b.st[1];
        if (nloc == 0u) { xcd_barrier_complete(bar, b.x, nloc, nx); b.st[0] = nloc; b.st[1] = nx; }
        const unsigned old = xb_add(&bar[XB_XSUB(b.x)], 1u);
        const unsigned gen = old / nloc;
        if (old + 1u == (gen + 1u) * nloc) {
            __builtin_amdgcn_fence(__ATOMIC_RELEASE, "agent");
            asm volatile("s_waitcnt vmcnt(0)" ::: "memory");
            const unsigned og = xb_add(&bar[XB_TOP], 1u);
            const unsigned tg = og / nx;
            if (og + 1u == (tg + 1u) * nx) xb_add(&bar[XB_TOPGEN], 1u);
            else XB_SPIN(xb_ld(&bar[XB_TOPGEN]) == tg, bar);
            __builtin_amdgcn_fence(__ATOMIC_ACQUIRE, "agent");
            xb_add(&bar[XB_XGEN(b.x)], 1u);
            asm volatile("s_waitcnt vmcnt(0)" ::: "memory");
        } else {
            XB_SPIN(xb_ld(&bar[XB_XGEN(b.x)]) == gen, bar);
            __builtin_amdgcn_fence(__ATOMIC_ACQUIRE, "agent");
            asm volatile("s_waitcnt vmcnt(0)" ::: "memory");
        }
    }
    __syncthreads();
}

__device__ __forceinline__ float wave_sum(float v) {
#pragma unroll
    for (int o = 1; o < 64; o <<= 1) v += __shfl_xor(v, o);
    return v;
}
constexpr int TR_PITCH = 65, TR_SCR_BYTES = 64 * TR_PITCH * 4;
template <int GU>
__device__ __forceinline__ void p0_transpose_item(const float* W, int N, const float* kscale, bf16* WT, int ldt, int koff, LAS float* scr, int item, int lane) {
    const int nblk = N / 64, kb = item / nblk, nb = item % nblk, k0 = 64 * kb, n0 = 64 * nb;
    const int q = lane >> 4, cc = lane & 15;
    f32x4 v[16];
#pragma unroll
    for (int i = 0; i < 16; ++i) v[i] = *(const GAS f32x4*)(W + (size_t)(k0 + 4 * i + q) * N + n0 + 4 * cc);
    const int c = lane & 7;
    f32x4 s0 = (f32x4){1.f, 1.f, 1.f, 1.f}, s1 = s0;
    if (kscale) { s0 = *(const GAS f32x4*)(kscale + k0 + 8 * c); s1 = *(const GAS f32x4*)(kscale + k0 + 8 * c + 4); }
#pragma unroll
    for (int i = 0; i < 16; ++i) { LAS float* d = scr + (4 * i + q) * TR_PITCH + 4 * cc; d[0] = v[i].x; d[1] = v[i].y; d[2] = v[i].z; d[3] = v[i].w; }
    LDS_WAIT(); asm volatile("" ::: "memory");
#pragma unroll
    for (int j = 0; j < 8; ++j) { const int n = (lane >> 3) + 8 * j; const LAS float* s = scr + (8 * c) * TR_PITCH + n;
        v4u o; o.x = pk2(s[0 * TR_PITCH] * s0.x, s[1 * TR_PITCH] * s0.y); o.y = pk2(s[2 * TR_PITCH] * s0.z, s[3 * TR_PITCH] * s0.w);
        o.z = pk2(s[4 * TR_PITCH] * s1.x, s[5 * TR_PITCH] * s1.y); o.w = pk2(s[6 * TR_PITCH] * s1.z, s[7 * TR_PITCH] * s1.w);
        const int ng = n0 + n; int drow;
        if (GU == 0) drow = ng;
        else if (GU == 3) { const int gsel = (ng >= 2304) ? 1 : 0, j = ng - 1280 - 1024 * gsel; drow = (ng < 1280) ? ng : (1280 + 256 * (j >> 7) + 128 * gsel + (j & 127)); }
        else drow = 256 * (ng >> 7) + (GU - 1) * 128 + (ng & 127);
        *(GAS v4u*)(WT + (size_t)drow * ldt + koff + k0 + 8 * c) = o; }
    LDS_WAIT(); asm volatile("" ::: "memory");
}
__device__ __forceinline__ void p0_pooleff_item(const float* wg, const float* scale, const float* wpb, bf16* WT, int item, int lane) {
    const int nblk = item & 15, cblk = (item >> 4) & 15, g = item >> 8;
    const int n = nblk * 64 + lane;
    const float* wgp = wg + (size_t)(g * 128 + cblk * 8) * 128;
    const float* bp = wpb + (size_t)(g * 128) * 1024 + n;
    const float* sp = scale + g * 128;
    float a0 = 0.f, a1 = 0.f, a2 = 0.f, a3 = 0.f, a4 = 0.f, a5 = 0.f, a6 = 0.f, a7 = 0.f;
#pragma unroll 1
    for (int j0 = 0; j0 < 128; j0 += 16) {
        float b[16];
#pragma unroll
        for (int u = 0; u < 16; ++u) b[u] = bp[(size_t)(j0 + u) * 1024];
#pragma unroll
        for (int u = 0; u < 16; ++u) { const float bb = b[u] * sp[j0 + u];
            a0 += wgp[0 * 128 + j0 + u] * bb; a1 += wgp[1 * 128 + j0 + u] * bb; a2 += wgp[2 * 128 + j0 + u] * bb; a3 += wgp[3 * 128 + j0 + u] * bb;
            a4 += wgp[4 * 128 + j0 + u] * bb; a5 += wgp[5 * 128 + j0 + u] * bb; a6 += wgp[6 * 128 + j0 + u] * bb; a7 += wgp[7 * 128 + j0 + u] * bb; }
    }
    v4u o; o.x = pk2(a0, a1); o.y = pk2(a2, a3); o.z = pk2(a4, a5); o.w = pk2(a6, a7);
    *(GAS v4u*)(WT + (size_t)n * 1024 + g * 128 + cblk * 8) = o;
}
constexpr int I_P = 1024, I_IN = (DM / 64) * (INW / 64), I_A = (512 / 64) * (DM / 64), I_O = (DM / 64) * (DM / 64), I_G = (DM / 64) * (DFF / 64), I_D = (DFF / 64) * (DM / 64);
constexpr int I_LAYER = I_P + I_IN + I_A + I_O + 2 * I_G + I_D;
__device__ __forceinline__ void convert_layer_items(const float* const* in, unsigned char* ws, int l, int first, int stride, LAS float* scr, int lane, int mode) {
    unsigned char* wl = ws + WS_W + (size_t)l * W_LAYER;
    const int count = mode == 0 ? I_IN : (mode == 1 ? I_LAYER - I_IN : I_LAYER);
    for (int it = first; it < count; it += stride) {
        int r = mode == 0 ? it + I_P : (mode == 1 ? (it < I_P ? it : it + I_IN) : it);
        if (r < I_P) { p0_pooleff_item(in[3] + (size_t)l * 4 * 128 * 128, in[4] + (size_t)l * POOLW, in[6] + (size_t)l * POOLW * DM, (bf16*)(wl + WO_PA), r, lane); continue; } r -= I_P;
        if (r < I_IN) { p0_transpose_item<3>(in[2] + (size_t)l * DM * INW, INW, in[1] + (size_t)l * DM, (bf16*)(wl + WO_IN), DM, 0, scr, r, lane); continue; } r -= I_IN;
        if (r < I_A) { p0_transpose_item<0>(in[7] + (size_t)l * 512 * DM, DM, nullptr, (bf16*)(wl + WO_PA), DM, 512, scr, r, lane); continue; } r -= I_A;
        if (r < I_O) { p0_transpose_item<0>(in[8] + (size_t)l * DM * DM, DM, nullptr, (bf16*)(wl + WO_OUT), DM, 0, scr, r, lane); continue; } r -= I_O;
        if (r < I_G) { p0_transpose_item<1>(in[10] + (size_t)l * DM * DFF, DFF, in[9] + (size_t)l * DM, (bf16*)(wl + WO_GU), DM, 0, scr, r, lane); continue; } r -= I_G;
        if (r < I_G) { p0_transpose_item<2>(in[11] + (size_t)l * DM * DFF, DFF, in[9] + (size_t)l * DM, (bf16*)(wl + WO_GU), DM, 0, scr, r, lane); continue; } r -= I_G;
        p0_transpose_item<0>(in[12] + (size_t)l * DFF * DM, DM, nullptr, (bf16*)(wl + WO_D), DFF, 0, scr, r, lane);
    }
}

constexpr int KS_PITCH = 72, VT_PITCH = 388, KS_BYTES = 384 * KS_PITCH * 2;
static_assert(KS_BYTES % 16 == 0 && KS_BYTES + 64 * VT_PITCH * 2 <= RING_BYTES, "attention LDS");
__device__ __forceinline__ int crow(int r, int hi) { return (r & 3) + 8 * (r >> 2) + 4 * hi; }
typedef float f32x2_t __attribute__((ext_vector_type(2))); typedef __bf16 bf16x2_t __attribute__((ext_vector_type(2)));
__device__ __forceinline__ unsigned cvtpk_rne(float lo, float hi) { f32x2_t v = {lo, hi}; bf16x2_t b = __builtin_convertvector(v, bf16x2_t); return __builtin_bit_cast(unsigned, b); }
__device__ __forceinline__ void attn_unit(LAS unsigned char* lds, const bf16* PROJ, bf16* DA, const float* sinkl, int unit, int tid, int wid, int lane) {
    const int n = unit & 31, hk = (unit >> 5) & 1, b = unit >> 6;
    LAS bf16* Ks = (LAS bf16*)lds;
    LAS bf16* Vt = (LAS bf16*)(lds + KS_BYTES);
    const size_t rowb = (size_t)b * SEQ;
    const int s0 = (n - 1) * 128;
#pragma unroll
    for (int hp = 0; hp < 2; ++hp) {
        v4u kreg[3], vreg[3];
#pragma unroll
        for (int i = 0; i < 3; ++i) {
            const int idx = tid + 512 * (3 * hp + i), c = idx >> 3, ch = idx & 7, s = s0 + c;
            if (s >= 0 && s < SEQ) { const bf16* p = PROJ + (rowb + s) * INW + 1024 + hk * 64 + ch * 8; kreg[i] = *(const v4u*)p; vreg[i] = *(const v4u*)(p + 128); }
            else { kreg[i] = (v4u){0u, 0u, 0u, 0u}; vreg[i] = (v4u){0u, 0u, 0u, 0u}; }
        }
#pragma unroll
        for (int i = 0; i < 3; ++i) {
            const int idx = tid + 512 * (3 * hp + i), c = idx >> 3, ch = idx & 7;
            *(LAS v4u*)(Ks + c * KS_PITCH + ch * 8) = kreg[i];
            LAS bf16* vp = Vt + (ch * 8) * VT_PITCH + c;
            vp[0 * VT_PITCH] = (bf16)(vreg[i].x & 0xffffu); vp[1 * VT_PITCH] = (bf16)(vreg[i].x >> 16);
            vp[2 * VT_PITCH] = (bf16)(vreg[i].y & 0xffffu); vp[3 * VT_PITCH] = (bf16)(vreg[i].y >> 16);
            vp[4 * VT_PITCH] = (bf16)(vreg[i].z & 0xffffu); vp[5 * VT_PITCH] = (bf16)(vreg[i].z >> 16);
            vp[6 * VT_PITCH] = (bf16)(vreg[i].w & 0xffffu); vp[7 * VT_PITCH] = (bf16)(vreg[i].w >> 16);
        }
    }
    __syncthreads();
    const int r32 = lane & 31, hi = lane >> 5;
    const int hq = hk * 4 + (wid >> 1);
    const float slope2 = __builtin_amdgcn_exp2f(-(float)(hq + 1)) * LOG2E;
    const float sink2 = sinkl[hq] * LOG2E;
    const float NEG = -INFINITY;
    const bool edge_n = (n == 0) || (n == 31);
#pragma unroll 1
    for (int sb = 0; sb < 2; ++sb) {
        const int a0 = 64 * (wid & 1) + 32 * sb, a = a0 + r32;
        const size_t qrow = rowb + (size_t)n * 128 + a;
        bf16x8 qf[4];
#pragma unroll
        for (int ks = 0; ks < 4; ++ks) qf[ks] = *(const bf16x8*)(PROJ + qrow * INW + 512 + hq * 64 + ks * 16 + hi * 8);
        float mrun = sink2, l = 0.f;
        f32x16 o0, o1;
#pragma unroll
        for (int r = 0; r < 16; ++r) { o0[r] = 0.f; o1[r] = 0.f; }
        const float fb0 = (float)(r32 + 128 - 4 * hi);
        f32x16 pn;
#define ATT_QK(dst, cblk) do { _Pragma("unroll") for (int r = 0; r < 16; ++r) dst[r] = 0.f; \
            _Pragma("unroll") for (int ks = 0; ks < 4; ++ks) { const bf16x8 kf = *(const LAS bf16x8*)(Ks + ((cblk) + r32) * KS_PITCH + ks * 16 + hi * 8); \
                dst = __builtin_amdgcn_mfma_f32_32x32x16_bf16(kf, qf[ks], dst, 0, 0, 0); } } while (0)
        ATT_QK(pn, a0);
#pragma unroll 1
        for (int i = 0; i < 9; ++i) {
            const int c0 = a0 + 32 * i;
            f32x16 p = pn;
            if (i < 8) ATT_QK(pn, c0 + 32);
            const float fb = fb0 - (float)(32 * i);
            const int sb0 = s0 + c0 + 4 * hi;
            const float kmin = fmaxf(fb - 128.0f, (float)(-sb0)), kmax = fminf(fb + 128.0f, (float)(SEQ - 1 - sb0));
            const float kmid = 0.5f * (kmin + kmax), khw = 0.5f * (kmax - kmin);
            float mx = NEG;
#pragma unroll
            for (int r = 0; r < 16; ++r) { const float kr = (float)((r & 3) + 8 * (r >> 2)); p[r] = p[r] - slope2 * fabsf(fb - kr); }
            if ((i == 0) || (i == 8) || edge_n) {
#pragma unroll
                for (int r = 0; r < 16; ++r) { const float kr = (float)((r & 3) + 8 * (r >> 2)); p[r] = (fabsf(kr - kmid) <= khw) ? p[r] : NEG; }
            }
#pragma unroll
            for (int r = 0; r < 16; ++r) mx = fmaxf(mx, p[r]);
            { const auto rr = __builtin_amdgcn_permlane32_swap(__float_as_uint(mx), __float_as_uint(mx), false, false); mx = fmaxf(__uint_as_float(rr[0]), __uint_as_float(rr[1])); }
            if (__any(mx > mrun + 8.0f)) {
                const float mnew = fmaxf(mrun, mx), alpha = __builtin_amdgcn_exp2f(mrun - mnew);
                mrun = mnew; l *= alpha;
#pragma unroll
                for (int r = 0; r < 16; ++r) { o0[r] *= alpha; o1[r] *= alpha; }
            }
            float ps = 0.f;
#pragma unroll
            for (int r = 0; r < 16; ++r) { p[r] = __builtin_amdgcn_exp2f(p[r] - mrun); ps += p[r]; }
            l += ps;
#pragma unroll
            for (int s = 0; s < 2; ++s) {
                v4u pw; pw.x = pg8::cvt_pk_bf16(p[8 * s + 0], p[8 * s + 1]); pw.y = pg8::cvt_pk_bf16(p[8 * s + 2], p[8 * s + 3]);
                pw.z = pg8::cvt_pk_bf16(p[8 * s + 4], p[8 * s + 5]); pw.w = pg8::cvt_pk_bf16(p[8 * s + 6], p[8 * s + 7]);
                const bf16x8 pb = __builtin_bit_cast(bf16x8, pw);
#pragma unroll
                for (int db = 0; db < 2; ++db) {
                    const LAS bf16* vp = Vt + (db * 32 + r32) * VT_PITCH + c0 + 16 * s + 4 * hi;
                    const s16x4 vlo = *(const LAS s16x4*)vp, vhi = *(const LAS s16x4*)(vp + 8);
                    const bf16x8 vf = (bf16x8){vlo[0], vlo[1], vlo[2], vlo[3], vhi[0], vhi[1], vhi[2], vhi[3]};
                    if (db == 0) o0 = __builtin_amdgcn_mfma_f32_32x32x16_bf16(vf, pb, o0, 0, 0, 0);
                    else         o1 = __builtin_amdgcn_mfma_f32_32x32x16_bf16(vf, pb, o1, 0, 0, 0);
                }
            }
        }
#undef ATT_QK
        { const auto rr = __builtin_amdgcn_permlane32_swap(__float_as_uint(l), __float_as_uint(l), false, false); l = __uint_as_float(rr[0]) + __uint_as_float(rr[1]); }
        const float inv = 1.0f / (l + __builtin_amdgcn_exp2f(sink2 - mrun));
        bf16* orow = DA + qrow * 1024 + 512 + hq * 64;
#pragma unroll
        for (int db = 0; db < 2; ++db)
#pragma unroll
            for (int rp = 0; rp < 2; ++rp) {
                const f32x16& oo = db == 0 ? o0 : o1; const int ra = 8 * rp, rb = 8 * rp + 4;
                unsigned ax = cvtpk_rne(oo[ra] * inv, oo[ra + 1] * inv), ay = cvtpk_rne(oo[ra + 2] * inv, oo[ra + 3] * inv);
                unsigned bx = cvtpk_rne(oo[rb] * inv, oo[rb + 1] * inv), by = cvtpk_rne(oo[rb + 2] * inv, oo[rb + 3] * inv);
                { const auto t = __builtin_amdgcn_permlane32_swap(ax, bx, false, false); ax = t[0]; bx = t[1]; }
                { const auto t = __builtin_amdgcn_permlane32_swap(ay, by, false, false); ay = t[0]; by = t[1]; }
                *(v4u*)(orow + 32 * db + 16 * rp + 8 * hi) = (v4u){ax, ay, bx, by};
            }
    }
    __syncthreads();
}
__device__ __forceinline__ v4u sel4(int g, v4u a, v4u b, v4u c, v4u d) {
    v4u r; r.x = g == 0 ? a.x : (g == 1 ? b.x : (g == 2 ? c.x : d.x)); r.y = g == 0 ? a.y : (g == 1 ? b.y : (g == 2 ? c.y : d.y));
    r.z = g == 0 ? a.z : (g == 1 ? b.z : (g == 2 ? c.z : d.z)); r.w = g == 0 ? a.w : (g == 1 ? b.w : (g == 2 ? c.w : d.w)); return r;
}
__device__ __forceinline__ void pool_tokens8(const bf16* PROJ, bf16* DA, int t0, int lane) {
    const int sf = t0 & (SEQ - 1), g = lane >> 4, half = 1 << g;
    const bf16* zp = PROJ + (size_t)t0 * INW + lane * 8;
    v4u row[23];
#pragma unroll
    for (int ri = 0; ri < 23; ++ri) {
        const int off = ri - 8, sp = sf + off;
        row[ri] = (v4u){0u, 0u, 0u, 0u};
        if ((off >= -half) && (off < 7 + half) && (sp >= 0) && (sp < SEQ)) row[ri] = *(const v4u*)(zp + (ptrdiff_t)off * INW);
    }
    float S0 = 0.f, S1 = 0.f, S2 = 0.f, S3 = 0.f, S4 = 0.f, S5 = 0.f, S6 = 0.f, S7 = 0.f;
#pragma unroll
    for (int off = -8; off < 8; ++off) {
        const float w = (off >= -half && off < half) ? 1.f : 0.f; const v4u v = row[8 + off];
        S0 += w * bflo(v.x); S1 += w * bfhi(v.x); S2 += w * bflo(v.y); S3 += w * bfhi(v.y); S4 += w * bflo(v.z); S5 += w * bfhi(v.z); S6 += w * bflo(v.w); S7 += w * bfhi(v.w);
    }
#pragma unroll
    for (int j = 0; j < 8; ++j) {
        if (j > 0) {
            const v4u vi = sel4(g, row[8 + j - 1 + 1], row[8 + j - 1 + 2], row[8 + j - 1 + 4], row[8 + j - 1 + 8]);
            const v4u vo = sel4(g, row[8 + j - 1 - 1], row[8 + j - 1 - 2], row[8 + j - 1 - 4], row[8 + j - 1 - 8]);
            S0 += bflo(vi.x) - bflo(vo.x); S1 += bfhi(vi.x) - bfhi(vo.x); S2 += bflo(vi.y) - bflo(vo.y); S3 += bfhi(vi.y) - bfhi(vo.y);
            S4 += bflo(vi.z) - bflo(vo.z); S5 += bfhi(vi.z) - bfhi(vo.z); S6 += bflo(vi.w) - bflo(vo.w); S7 += bfhi(vi.w) - bfhi(vo.w);
        }
        const int s = sf + j, lo = (s - half) < 0 ? 0 : (s - half), hi = (s + half) > SEQ ? SEQ : (s + half);
        const float ic = 1.0f / (float)(hi - lo);
        const v4u zc = row[8 + j];
        v4u o; o.x = pk2(S0 * ic - bflo(zc.x), S1 * ic - bfhi(zc.x)); o.y = pk2(S2 * ic - bflo(zc.y), S3 * ic - bfhi(zc.y));
        o.z = pk2(S4 * ic - bflo(zc.z), S5 * ic - bfhi(zc.z)); o.w = pk2(S6 * ic - bflo(zc.w), S7 * ic - bfhi(zc.w));
        *(v4u*)(DA + (size_t)(t0 + j) * 1024 + lane * 8) = o;
    }
}

__device__ __forceinline__ void xcc_local_barrier(unsigned* bar2, unsigned x, unsigned nloc, unsigned* tmobar) {
    asm volatile("s_waitcnt vmcnt(0)" ::: "memory");
    __syncthreads();
    if (threadIdx.x == 0) {
        const unsigned old = xb_add(&bar2[XB_XSUB(x)], 1u);
        const unsigned gen = old / nloc;
        if (old + 1u == (gen + 1u) * nloc) (void)xb_add(&bar2[XB_XGEN(x)], 1u);
        else XB_SPIN(xb_ld(&bar2[XB_XGEN(x)]) == gen, tmobar);
        __builtin_amdgcn_fence(__ATOMIC_ACQUIRE, "agent");
        asm volatile("s_waitcnt vmcnt(0)" ::: "memory");
    }
    __syncthreads();
}

#ifndef DBG_MASK
#define DBG_MASK 255
#endif
#ifndef DBG_DOUBLE
#define DBG_DOUBLE 0
#endif
struct Args { const float* in[14]; float* out; unsigned char* ws; int ph_lo, ph_hi, li, pad; };
__global__ void __launch_bounds__(NWAVES * 64, 2) mk_fwd(Args args) {
    extern __shared__ __attribute__((aligned(16))) unsigned char lds_raw[];
    LAS unsigned char* lds = (LAS unsigned char*)lds_raw;
    volatile LAS unsigned* MISC = (volatile LAS unsigned*)(lds + MISC_OFF);
    const int tid = threadIdx.x, wave = __builtin_amdgcn_readfirstlane(tid >> 6);
#define lane (tid & 63)
    const int G = gridDim.x; int vcu; { const int bx = blockIdx.x; vcu = (G % 8 == 0) ? (bx % 8) * (G / 8) + bx / 8 : bx; }
    unsigned char* ws = args.ws;
    unsigned* ctl = (unsigned*)(ws + WS_CTL);
    float* ssq = (float*)(ctl + CW_SSQ);
#define SSQ_ARR(k) ((k) == 0 ? ssq : ((k) == 4 ? (float*)(ws + 1 * MiB) : (float*)args.out + (size_t)((k) - 1) * 4096))
#define SSQ_PS(k) (((k) >= 1 && (k) <= 3) ? 262144 : 4096)
#define SSQ_NP(k) ((k) == 0 ? 1 : 16)
    LAS float* rtab = (LAS float*)(lds + LDSCTL_OFF + 1024);
#define RSTD_TABLE(arr, np_, ps_) { pg8::Unit u0; const bool any = S.next(0, u0); __syncthreads(); \
        if (any && tid < 256) rtab[tid] = rsqrtf(pg8::row_ssq((arr), (np_), u0.pm * 256 + tid, (ps_)) * (1.0f / 1024.0f) + pg8::RMS_EPS); __syncthreads(); }
    float* out = args.out;
    bf16* HB = (bf16*)(ws + WS_HB); bf16* DA = (bf16*)(ws + WS_DA); bf16* MG = (bf16*)(ws + WS_MG); bf16* PROJ = (bf16*)(ws + WS_PROJ); bf16* ACT = PROJ;
    for (int u = tid; u < (LDS_BYTES - LDSCTL_OFF) / 4; u += NWAVES * 64) ((LAS unsigned*)(lds + LDSCTL_OFF))[u] = 0u;
    __syncthreads();
    XcdBarrier bar; bar.bar = ctl + CW_BAR; bar.x = 0; bar.st = nullptr;
    if (N_LAUNCHES == 1) bar = xcd_barrier_post(ctl + CW_BAR, MISC + 8);
    if (N_LAUNCHES == 1 && tid == 0) ctl[CW_XCCTAB + blockIdx.x] = bar.x + 1u;
    const int lo = args.ph_lo, hi = args.ph_hi;
#define IN(k) (lo <= (k) && (k) < hi)
#ifdef DBG_XBAR
#define SEAM(k) do { if (IN(k) && IN((k) + 1)) { xcd_barrier(bar); xcd_barrier(bar); } } while (0)
#else
#define SEAM(k) do { if (IN(k) && IN((k) + 1)) xcd_barrier(bar); } while (0)
#endif
    const int gw = vcu * NWAVES + wave, NGW = G * NWAVES;
    bool xl_fast = false;
#ifndef MK_GRID_SEAMS_ONLY
#define SEAM_G(k) do { if (IN(k) && IN((k) + 1)) { if (xl_fast) xcc_local_barrier(ctl + CW_BAR2, bar.x, bar.st[0], bar.bar); else xcd_barrier(bar); } } while (0)
#else
#define SEAM_G(k) SEAM(k)
#endif

    for (int rep = 0; rep < ((DBG_DOUBLE & 1) ? 2 : 1); ++rep)
    if (IN(0) && (DBG_MASK & 1)) {
        LAS float* scr = (LAS float*)(lds + RING_OFF + wave * TR_SCR_BYTES);
        convert_layer_items(args.in, ws, 0, gw, NGW, scr, lane, 0);
        const float* x = args.in[0];
        for (int m = gw; m < M; m += 2 * NGW) {
            const int m1 = m + NGW;
            const bool has1 = m1 < M;
            const GAS f32x4* xr0 = (const GAS f32x4*)(x + (size_t)m * DM) + lane;
            const GAS f32x4* xr1 = (const GAS f32x4*)(x + (size_t)(has1 ? m1 : m) * DM) + lane;
            f32x4 v0[4], v1[4]; float s0 = 0.f, s1 = 0.f;
#pragma unroll
            for (int j = 0; j < 4; ++j) { v0[j] = xr0[64 * j]; v1[j] = xr1[64 * j]; }
#pragma unroll
            for (int j = 0; j < 4; ++j) { s0 += (v0[j].x * v0[j].x + v0[j].y * v0[j].y) + (v0[j].z * v0[j].z + v0[j].w * v0[j].w); s1 += (v1[j].x * v1[j].x + v1[j].y * v1[j].y) + (v1[j].z * v1[j].z + v1[j].w * v1[j].w); }
            s0 = wave_sum(s0); s1 = wave_sum(s1);
            GAS unsigned long long* o0 = (GAS unsigned long long*)(HB + (size_t)m * DM) + lane;
#pragma unroll
            for (int j = 0; j < 4; ++j) o0[64 * j] = (unsigned long long)pk2(v0[j].x, v0[j].y) | ((unsigned long long)pk2(v0[j].z, v0[j].w) << 32);
            if (lane == 0) ssq[m] = s0;
            if (has1) {
                GAS unsigned long long* o1 = (GAS unsigned long long*)(HB + (size_t)m1 * DM) + lane;
#pragma unroll
                for (int j = 0; j < 4; ++j) o1[64 * j] = (unsigned long long)pk2(v1[j].x, v1[j].y) | ((unsigned long long)pk2(v1[j].z, v1[j].w) << 32);
                if (lane == 0) ssq[m1] = s1;
            }
        }
    }
    SEAM(0);
    if (N_LAUNCHES == 1 && IN(0) && IN(1) && G == 256) {
        if (wave == 0) {
            const int t = tid;
            const unsigned* tab = ctl + CW_XCCTAB + (t >> 3) + 8 * (t & 7);
            const unsigned i0 = tab[0], i1 = tab[64], i2 = tab[128], i3 = tab[192];
            const bool same = (i0 != 0u) && (i0 == i1) && (i0 == i2) && (i0 == i3);
            const bool all = __all(same);
            if (tid == 0) MISC[12] = all ? 1u : 0u;
        }
        __syncthreads();
        xl_fast = (MISC[12] != 0u);
    }

#pragma unroll 1
    for (int l = 0; l < DEPTH; ++l) {
        const int pb = 1 + 6 * l;
        unsigned char* wl = ws + WS_W + (size_t)l * W_LAYER;
        for (int rep = 0; rep < ((DBG_DOUBLE & 2) ? 2 : 1); ++rep)
        if (IN(pb + 0) && (DBG_MASK & 2)) {
            pg8::Gemm g{HB, (const bf16*)(wl + WO_IN), DM, DM, DM}; pg8::StaticOrder S; S.init(M, INW, G, (int)blockIdx.x, 1, G == 256 ? 1 : 0);
            RSTD_TABLE(SSQ_ARR(2 * l), SSQ_NP(2 * l), SSQ_PS(2 * l));
            pg8::EpiProj E{PROJ, rtab};
            pg8::gemm_phase<pg8::EpiProj, pg8::StaticOrder, true, true>(lds + RING_OFF, g, S, E);
            {
                const int rem = ((M / 256) * (INW / 256)) % G;
                int lane_o = lane; asm volatile("" : "+v"(lane_o));
                if ((int)blockIdx.x >= rem) convert_layer_items(args.in, ws, l, ((int)blockIdx.x - rem) * NWAVES + wave, (G - rem) * NWAVES, (LAS float*)(lds + RING_OFF + wave * TR_SCR_BYTES), lane_o, 1);
                if (DBG_DOUBLE) __syncthreads();
            }
        }
        SEAM(pb + 0);
        for (int rep = 0; rep < ((DBG_DOUBLE & 4) ? 2 : 1); ++rep)
        if (IN(pb + 1) && (DBG_MASK & 4)) {
            int tid_o = tid; asm volatile("" : "+v"(tid_o));
            if (G == 256) {
                const int bx = (int)blockIdx.x, pmc = (bx % 8) * 8 + (bx / 8) % 8, j = bx / 64;
                attn_unit(lds + RING_OFF, PROJ, DA, args.in[5] + l * 8, (pmc / 16) * 64 + (j & 1) * 32 + 2 * (pmc % 16) + (j >> 1), tid_o, wave, tid_o & 63);
                pool_tokens8(PROJ, DA, 256 * pmc + 64 * j + 8 * wave, tid_o & 63);
            } else {
                for (int u = vcu; u < BATCH * 2 * 32; u += G) attn_unit(lds + RING_OFF, PROJ, DA, args.in[5] + l * 8, u, tid_o, wave, tid_o & 63);
                for (int t8 = gw; t8 < M / 8; t8 += NGW) pool_tokens8(PROJ, DA, t8 * 8, tid_o & 63);
            }
        }
        SEAM_G(pb + 1);
        if (xl_fast && (int)blockIdx.x < 64 && tid == 0) (void)xb_add(ctl + CW_PBD + 64 * (((int)blockIdx.x % 8) * 8 + ((int)blockIdx.x / 8) % 8), 1u);
        for (int rep = 0; rep < ((DBG_DOUBLE & 8) ? 2 : 1); ++rep)
        if (IN(pb + 2) && (DBG_MASK & 8)) {
            pg8::Gemm g{DA, (const bf16*)(wl + WO_PA), DM, DM, 512}; pg8::StaticOrder S; S.init(M, DM, G, (int)blockIdx.x, 2);
            pg8::EpiMerge E{PROJ, MG};
            pg8::gemm_phase<pg8::EpiMerge, pg8::StaticOrder, true, true>(lds + RING_OFF, g, S, E);
        }
        SEAM_G(pb + 2);
        for (int rep = 0; rep < (((DBG_DOUBLE & 16) && l == 0) ? 2 : 1); ++rep)
        if (IN(pb + 3) && (DBG_MASK & 16)) {
            pg8::Gemm g{MG, (const bf16*)(wl + WO_OUT), DM, DM, DM}; pg8::StaticOrder S; S.init(M, DM, G, (int)blockIdx.x, 1);
            pg8::EpiResid E{HB, HB, SSQ_ARR(2 * l + 1), SSQ_PS(2 * l + 1)};
            pg8::gemm_phase<pg8::EpiResid, pg8::StaticOrder, false, true>(lds + RING_OFF, g, S, E);
        }
        SEAM_G(pb + 3);
        for (int rep = 0; rep < ((DBG_DOUBLE & 32) ? 2 : 1); ++rep)
        if (IN(pb + 4) && (DBG_MASK & 32)) {
            pg8::Gemm g{HB, (const bf16*)(wl + WO_GU), DM, DM, DM}; pg8::StaticOrder S; S.init(M, NGU, G, (int)blockIdx.x, 1);
            if (xl_fast && tid == 0) {
                const int pmc = ((int)blockIdx.x % 8) * 8 + ((int)blockIdx.x / 8) % 8;
                if (pmc > 0)  XB_SPIN(xb_ld(ctl + CW_PBD + 64 * (pmc - 1)) < (unsigned)(l + 1), bar.bar);
                if (pmc < 63) XB_SPIN(xb_ld(ctl + CW_PBD + 64 * (pmc + 1)) < (unsigned)(l + 1), bar.bar);
            }
            RSTD_TABLE(SSQ_ARR(2 * l + 1), 16, SSQ_PS(2 * l + 1));
            pg8::EpiSwiglu E{ACT, rtab};
            pg8::gemm_phase<pg8::EpiSwiglu, pg8::StaticOrder, true, true>(lds + RING_OFF, g, S, E);
            if (l + 1 < DEPTH) {
                const int rem = ((M / 256) * (NGU / 256)) % G;
                int lane_o = lane; asm volatile("" : "+v"(lane_o));
                if ((int)blockIdx.x >= rem) convert_layer_items(args.in, ws, l + 1, ((int)blockIdx.x - rem) * NWAVES + wave, (G - rem) * NWAVES, (LAS float*)(lds + RING_OFF + wave * TR_SCR_BYTES), lane_o, 0);
                if (DBG_DOUBLE) __syncthreads();
            }
        }
        SEAM_G(pb + 4);
        if (IN(pb + 5) && (DBG_MASK & 64)) {
            pg8::Gemm g{ACT, (const bf16*)(wl + WO_D), INW, DFF, DFF};     pg8::StaticOrder S; S.init(M, DM, G, (int)blockIdx.x, 1);
            pg8::EpiResid E{HB, HB, SSQ_ARR(2 * l + 2), SSQ_PS(2 * l + 2)};
            pg8::gemm_phase<pg8::EpiResid, pg8::StaticOrder, false, true>(lds + RING_OFF, g, S, E);
        }
        if (l == DEPTH - 1) SEAM_G(pb + 5); else SEAM(pb + 5);
    }
    if (IN(N_PHASES - 1) && (DBG_MASK & 128)) {
        const float* gain = args.in[13]; const float* sq = SSQ_ARR(2 * DEPTH);
        f32x4 gv[4];
#pragma unroll
        for (int j = 0; j < 4; ++j) gv[j] = ((const GAS f32x4*)gain)[2 * lane + (j & 1) + 128 * (j >> 1)];
        const bool own = (G == 256);
        const int fbase = own ? 256 * (((int)blockIdx.x % 8) * 8 + ((int)blockIdx.x / 8) % 8) + 64 * ((int)blockIdx.x / 64) + 8 * wave : gw;
        const int fstep = own ? 2 : 2 * NGW, fend = own ? fbase + 8 : M, fsec = own ? 1 : NGW;
        for (int m = fbase; m < fend; m += fstep) {
            const int m1 = (m + fsec < fend) ? m + fsec : m;
            const v4u a0 = *(const GAS v4u*)(HB + (size_t)m * DM + 8 * lane), a1 = *(const GAS v4u*)(HB + (size_t)m * DM + 512 + 8 * lane);
            const v4u b0 = *(const GAS v4u*)(HB + (size_t)m1 * DM + 8 * lane), b1 = *(const GAS v4u*)(HB + (size_t)m1 * DM + 512 + 8 * lane);
            const float rs0 = rsqrtf(pg8::row_ssq(sq, 16, m, SSQ_PS(2 * DEPTH)) * (1.0f / 1024.0f) + pg8::RMS_EPS), rs1 = rsqrtf(pg8::row_ssq(sq, 16, m1, SSQ_PS(2 * DEPTH)) * (1.0f / 1024.0f) + pg8::RMS_EPS);
            GAS f32x4* o0 = (GAS f32x4*)(out + (size_t)m * DM + 8 * lane); GAS f32x4* o1 = (GAS f32x4*)(out + (size_t)m1 * DM + 8 * lane);
            o0[0] = (f32x4){bflo(a0.x), bfhi(a0.x), bflo(a0.y), bfhi(a0.y)} * rs0 * gv[0]; o0[1] = (f32x4){bflo(a0.z), bfhi(a0.z), bflo(a0.w), bfhi(a0.w)} * rs0 * gv[1];
            o0[128] = (f32x4){bflo(a1.x), bfhi(a1.x), bflo(a1.y), bfhi(a1.y)} * rs0 * gv[2]; o0[129] = (f32x4){bflo(a1.z), bfhi(a1.z), bflo(a1.w), bfhi(a1.w)} * rs0 * gv[3];
            if (m1 != m) {
                o1[0] = (f32x4){bflo(b0.x), bfhi(b0.x), bflo(b0.y), bfhi(b0.y)} * rs1 * gv[0]; o1[1] = (f32x4){bflo(b0.z), bfhi(b0.z), bflo(b0.w), bfhi(b0.w)} * rs1 * gv[1];
                o1[128] = (f32x4){bflo(b1.x), bfhi(b1.x), bflo(b1.y), bfhi(b1.y)} * rs1 * gv[2]; o1[129] = (f32x4){bflo(b1.z), bfhi(b1.z), bflo(b1.w), bfhi(b1.w)} * rs1 * gv[3];
            }
        }
    }
#undef lane
#undef IN
#undef SEAM
#undef SEAM_G
}

extern "C" void kernel_launch(void* const* d_in, const int* in_sizes, int n_in, void* d_out, int out_size, void* d_ws, size_t ws_size, hipStream_t stream) {
    static int grid = 0;
    if (grid == 0) {
        if (n_in != 14 || in_sizes[0] != M * DM || out_size != M * DM || ws_size < WS_END) { fprintf(stderr, "kernel_launch: unexpected shapes (n_in %d, in0 %d, out %d, ws %zu); nothing launched\n", n_in, n_in > 0 ? in_sizes[0] : -1, out_size, ws_size); grid = -1; return; }
        int dev = 0, cus = 0, per_cu = 0;
        if (hipGetDevice(&dev) != hipSuccess || hipDeviceGetAttribute(&cus, hipDeviceAttributeMultiprocessorCount, dev) != hipSuccess) { grid = -1; return; }
        if (hipFuncSetAttribute((const void*)mk_fwd, hipFuncAttributeMaxDynamicSharedMemorySize, LDS_BYTES) != hipSuccess) { fprintf(stderr, "kernel_launch: hipFuncSetAttribute failed\n"); grid = -1; return; }
        if (hipOccupancyMaxActiveBlocksPerMultiprocessor(&per_cu, (const void*)mk_fwd, NWAVES * 64, LDS_BYTES) != hipSuccess || per_cu < 1) fprintf(stderr, "kernel_launch: occupancy query reports %d workgroups per CU\n", per_cu);
        (void)hipGetLastError();
        grid = cus >= 64 ? (cus / 64) * 64 : cus;
        if (grid % 64 != 0) { fprintf(stderr, "kernel_launch: needs a grid that is a multiple of 64 workgroups (got %d CUs); nothing launched\n", cus); grid = -1; return; }
    }
    if (grid < 0) return;
    if (hipMemsetAsync((char*)d_ws + WS_CTL, 0, CTL_ZERO_BYTES, stream) != hipSuccess) { fprintf(stderr, "kernel_launch: hipMemsetAsync failed\n"); return; }
    Args a{};
    for (int i = 0; i < 14; ++i) a.in[i] = (const float*)d_in[i];
    a.out = (float*)d_out; a.ws = (unsigned char*)d_ws;
    if (N_LAUNCHES == 1) {
        a.ph_lo = 0; a.ph_hi = N_PHASES; a.li = 0;
        hipLaunchKernelGGL(mk_fwd, dim3(grid), dim3(NWAVES * 64), LDS_BYTES, stream, a);
    } else {
        for (int li = 0; li < N_PHASES; ++li) { a.ph_lo = li; a.ph_hi = li + 1; a.li = li; hipLaunchKernelGGL(mk_fwd, dim3(grid), dim3(NWAVES * 64), LDS_BYTES, stream, a); }
    }
}
```
